# Optimizing an MI355X kernel written in HIP

```python
import math
import jax, jax.numpy as jnp
from jax import lax
import numpy as np

D_MODEL = 1024
BATCH = 4
SEQ = 8192
DEPTH = 4
DEC_BATCH = 32
DEC_SEQ = 32
PAST_LEN = 1024

CHUNK = 64
Q_BLOCK = 128
HEAD_DIM = 64
H_SB = 8
H_DIFF = 4
H_BAND = 16
BAND_CHUNKS = 8
BAND_PAST = BAND_CHUNKS * CHUNK
BAND = BAND_PAST + CHUNK
REL_CLIP = 128
ROPE_THETA = 10000.0
FFN_HIDDEN = ((8 * D_MODEL + 3 * 256 - 1) // (3 * 256)) * 256
PLE_DIM = 256
N_EVEN = (DEPTH + 1) // 2
N_ODD = DEPTH // 2
EPS = 1e-6
SCALE = HEAD_DIM ** -0.5
NEG = -1e30
W_SB = H_SB * HEAD_DIM
W_DIFF_QK = H_DIFF * 2 * HEAD_DIM
W_DIFF_V = H_DIFF * 2 * HEAD_DIM
W_EVEN_IN = 3 * W_SB + 2 * W_DIFF_QK + W_DIFF_V
W_EVEN_OUT = W_SB + W_DIFF_V
W_BAND = H_BAND * HEAD_DIM
W_ODD_IN = 3 * W_BAND

kernel_name = "stickbreak_diff_chunkband_streaming_trunk"


def rmsnorm(x, g):
    xf = x.astype(jnp.float32)
    y = xf * lax.rsqrt(jnp.mean(xf * xf, axis=-1, keepdims=True) + EPS)
    return (y * g.astype(jnp.float32)).astype(x.dtype)


def rope(x, pos):
    half = HEAD_DIM // 2
    inv = ROPE_THETA ** (-jnp.arange(half, dtype=jnp.float32) / half)
    ang = pos.astype(jnp.float32)[:, None] * inv[None, :]
    shape = (1, ang.shape[0]) + (1,) * (x.ndim - 3) + (half,)
    cos = jnp.cos(ang).reshape(shape)
    sin = jnp.sin(ang).reshape(shape)
    xf = x.astype(jnp.float32)
    x1, x2 = xf[..., :half], xf[..., half:]
    return jnp.concatenate([x1 * cos - x2 * sin, x2 * cos + x1 * sin], axis=-1).astype(x.dtype)


def stick_breaking(q, k, v, q_pos, k_pos):
    z = jnp.einsum("bqhd,bkhd->bhqk", q, k).astype(jnp.float32) * SCALE
    mask = k_pos[None, :] < q_pos[:, None]
    log_beta = jax.nn.log_sigmoid(z)
    log_keep = jnp.where(mask, jax.nn.log_sigmoid(-z), 0.0)
    after = lax.cumsum(log_keep, axis=3, reverse=True) - log_keep
    w = jnp.where(mask, jnp.exp(log_beta + after), 0.0)
    return jnp.einsum("bhqk,bkhd->bqhd", w.astype(v.dtype), v)


def diff_attn(q, k, v, q_pos, k_pos, lam, gain, lam_init):
    s = jnp.einsum("bqhmd,bkhmd->bhmqk", q, k).astype(jnp.float32) * SCALE
    mask = (k_pos // CHUNK)[None, :] <= (q_pos // CHUNK)[:, None]
    pr = jax.nn.softmax(jnp.where(mask, s, NEG), axis=-1)
    a = pr[:, :, 0] - lam * pr[:, :, 1]
    o = jnp.einsum("bhqk,bkhe->bqhe", a.astype(v.dtype), v).astype(jnp.float32)
    o = o * lax.rsqrt(jnp.mean(o * o, axis=-1, keepdims=True) + EPS)
    o = o * gain.astype(jnp.float32)[None, None] * (1.0 - lam_init)
    return o.astype(v.dtype)


def band_attn(q, kb, vb, q_pos, k_pos, k_valid, bias):
    s = jnp.einsum("bqhd,bkhd->bhqk", q, kb).astype(jnp.float32) * SCALE
    idx = jnp.clip(q_pos[:, None] - k_pos[None, :], -REL_CLIP, REL_CLIP) + REL_CLIP
    s = s + bias.astype(jnp.float32)[:, idx][None]
    pr = jax.nn.softmax(jnp.where(k_valid[None, None, None, :], s, NEG), axis=-1)
    return jnp.einsum("bhqk,bkhd->bqhd", pr.astype(vb.dtype), vb)


def blocked_queries(fn, q, q_pos):
    B, S = q.shape[0], q.shape[1]
    nb = S // Q_BLOCK
    qb = jnp.moveaxis(q.reshape((B, nb, Q_BLOCK) + q.shape[2:]), 1, 0)
    pb = q_pos.reshape(nb, Q_BLOCK)
    ob = lax.map(lambda a: fn(a[0], a[1]), (qb, pb))
    return jnp.moveaxis(ob, 0, 1).reshape((B, S) + ob.shape[3:])


def band_prompt(q, k, v, bias):
    B, S = q.shape[0], q.shape[1]
    nc = S // CHUNK
    pad = ((0, 0), (BAND_PAST, 0), (0, 0), (0, 0))
    kp = jnp.pad(k, pad)
    vp = jnp.pad(v, pad)
    qc = jnp.moveaxis(q.reshape(B, nc, CHUNK, H_BAND, HEAD_DIM), 1, 0)

    def one(args):
        qi, c = args
        start = c * CHUNK
        kb = lax.dynamic_slice_in_dim(kp, start, BAND, axis=1)
        vb = lax.dynamic_slice_in_dim(vp, start, BAND, axis=1)
        q_pos = start + jnp.arange(CHUNK, dtype=jnp.int32)
        k_pos = start - BAND_PAST + jnp.arange(BAND, dtype=jnp.int32)
        return band_attn(qi, kb, vb, q_pos, k_pos, k_pos >= 0, bias)

    oc = lax.map(one, (qc, jnp.arange(nc, dtype=jnp.int32)))
    return jnp.moveaxis(oc, 0, 1).reshape(B, S, H_BAND, HEAD_DIM)


def even_proj(hn, w_in, pos):
    B, T = hn.shape[0], hn.shape[1]
    z = hn @ w_in
    cuts = [W_SB, 2 * W_SB, 3 * W_SB, 3 * W_SB + W_DIFF_QK, 3 * W_SB + 2 * W_DIFF_QK]
    q_a, k_a, v_a, q_b, k_b, v_b = jnp.split(z, cuts, axis=-1)
    q_a = q_a.reshape(B, T, H_SB, HEAD_DIM)
    k_a = k_a.reshape(B, T, H_SB, HEAD_DIM)
    v_a = v_a.reshape(B, T, H_SB, HEAD_DIM)
    q_b = rope(q_b.reshape(B, T, H_DIFF, 2, HEAD_DIM), pos)
    k_b = rope(k_b.reshape(B, T, H_DIFF, 2, HEAD_DIM), pos)
    v_b = v_b.reshape(B, T, H_DIFF, 2 * HEAD_DIM)
    return q_a, k_a, v_a, q_b, k_b, v_b


def odd_proj(hn, w_in):
    B, T = hn.shape[0], hn.shape[1]
    q, k, v = jnp.split(hn @ w_in, [W_BAND, 2 * W_BAND], axis=-1)
    shp = (B, T, H_BAND, HEAD_DIM)
    return q.reshape(shp), k.reshape(shp), v.reshape(shp)


def trunk(x, p, pos, past, norm_mix, w_in_even, w_out_even, diff_lambda, diff_norm,
          w_in_odd, w_out_odd, rel_bias, norm_ffn, w_gate, w_up, w_down,
          norm_ple, w_ple_gate, w_ple, norm_final):
    B, T = x.shape[0], x.shape[1]
    sb_k, sb_v, df_k, df_v, bd_k, bd_v = [], [], [], [], [], []
    h = x
    for li in range(DEPTH):
        hn = rmsnorm(h, norm_mix[li])
        if li % 2 == 0:
            e = li // 2
            q_a, k_a, v_a, q_b, k_b, v_b = even_proj(hn, w_in_even[e], pos)
            lam_init = 0.8 - 0.6 * math.exp(-0.3 * li)
            lp = diff_lambda[e].astype(jnp.float32)
            lam = jnp.exp(jnp.sum(lp[0] * lp[1])) - jnp.exp(jnp.sum(lp[2] * lp[3])) + lam_init
            gain = diff_norm[e]
            if past is None:
                o_a = blocked_queries(lambda qi, pi: stick_breaking(qi, k_a, v_a, pi, pos), q_a, pos)
                o_b = blocked_queries(lambda qi, pi: diff_attn(qi, k_b, v_b, pi, pos, lam, gain, lam_init), q_b, pos)
            else:
                past_len = past[0].shape[2]
                k_pos = jnp.concatenate([jnp.arange(past_len, dtype=jnp.int32), pos])
                ka = jnp.concatenate([past[0][e], k_a], axis=1)
                va = jnp.concatenate([past[1][e], v_a], axis=1)
                kb = jnp.concatenate([past[2][e], k_b], axis=1)
                vb = jnp.concatenate([past[3][e], v_b], axis=1)
                o_a = stick_breaking(q_a, ka, va, pos, k_pos)
                o_b = diff_attn(q_b, kb, vb, pos, k_pos, lam, gain, lam_init)
            sb_k.append(k_a)
            sb_v.append(v_a)
            df_k.append(k_b)
            df_v.append(v_b)
            o = jnp.concatenate([o_a.reshape(B, T, W_SB), o_b.reshape(B, T, W_DIFF_V)], axis=-1)
            h = h + o @ w_out_even[e]
        else:
            od = li // 2
            q, k, v = odd_proj(hn, w_in_odd[od])
            if past is None:
                o = band_prompt(q, k, v, rel_bias[od])
                keep = min(BAND_PAST, T)
                bd_k.append(k[:, T - keep:])
                bd_v.append(v[:, T - keep:])
            else:
                ck, cv = past[4][od], past[5][od]
                rows = ck.shape[1]
                past_len = past[0].shape[2]
                k_pos = jnp.concatenate([past_len - rows + jnp.arange(rows, dtype=jnp.int32), pos])
                kb = jnp.concatenate([ck, k], axis=1)
                vb = jnp.concatenate([cv, v], axis=1)
                o = band_attn(q, kb, vb, pos, k_pos, jnp.ones((rows + T,), dtype=bool), rel_bias[od])
                bd_k.append(k)
                bd_v.append(v)
            h = h + o.reshape(B, T, W_BAND) @ w_out_odd[od]
        hn = rmsnorm(h, norm_ffn[li])
        h = h + (jax.nn.silu(hn @ w_gate[li]) * (hn @ w_up[li])) @ w_down[li]
        gate = jax.nn.sigmoid(rmsnorm(h, norm_ple[li]) @ w_ple_gate[li])
        h = h + (p[li] @ w_ple[li]) * gate
    y = rmsnorm(h, norm_final)
    return y, (jnp.stack(sb_k), jnp.stack(sb_v), jnp.stack(df_k), jnp.stack(df_v), jnp.stack(bd_k), jnp.stack(bd_v))


def setup_inputs(seed: int = 0) -> dict:
    key = jax.random.key(seed)
    ks = jax.random.split(key, 26)
    f32 = jnp.float32
    nrm = lambda k, shp, s=1.0: jax.random.normal(k, shp, dtype=f32) * s
    band_rows = min(BAND_PAST, PAST_LEN)
    return {
        "x_prompt": nrm(ks[0], (BATCH, SEQ, D_MODEL)),
        "x_sample": nrm(ks[1], (DEC_BATCH, DEC_SEQ, D_MODEL)),
        "cache_sb_k": nrm(ks[2], (N_EVEN, DEC_BATCH, PAST_LEN, H_SB, HEAD_DIM)),
        "cache_sb_v": nrm(ks[3], (N_EVEN, DEC_BATCH, PAST_LEN, H_SB, HEAD_DIM)),
        "cache_diff_k": nrm(ks[4], (N_EVEN, DEC_BATCH, PAST_LEN, H_DIFF, 2, HEAD_DIM)),
        "cache_diff_v": nrm(ks[5], (N_EVEN, DEC_BATCH, PAST_LEN, H_DIFF, 2 * HEAD_DIM)),
        "cache_band_k": nrm(ks[6], (N_ODD, DEC_BATCH, band_rows, H_BAND, HEAD_DIM)),
        "cache_band_v": nrm(ks[7], (N_ODD, DEC_BATCH, band_rows, H_BAND, HEAD_DIM)),
        "p_prompt": nrm(ks[8], (DEPTH, BATCH, SEQ, PLE_DIM)),
        "p_sample": nrm(ks[9], (DEPTH, DEC_BATCH, DEC_SEQ, PLE_DIM)),
        "norm_mix": 1.0 + nrm(ks[10], (DEPTH, D_MODEL), 0.01),
        "w_in_even": nrm(ks[11], (N_EVEN, D_MODEL, W_EVEN_IN), D_MODEL ** -0.5),
        "w_out_even": nrm(ks[12], (N_EVEN, W_EVEN_OUT, D_MODEL), W_EVEN_OUT ** -0.5),
        "diff_lambda": nrm(ks[13], (N_EVEN, 4, HEAD_DIM), 0.1),
        "diff_norm": 1.0 + nrm(ks[14], (N_EVEN, H_DIFF, 2 * HEAD_DIM), 0.01),
        "w_in_odd": nrm(ks[15], (N_ODD, D_MODEL, W_ODD_IN), D_MODEL ** -0.5),
        "w_out_odd": nrm(ks[16], (N_ODD, W_BAND, D_MODEL), W_BAND ** -0.5),
        "rel_bias": nrm(ks[17], (N_ODD, H_BAND, 2 * REL_CLIP + 1), 0.5),
        "norm_ffn": 1.0 + nrm(ks[18], (DEPTH, D_MODEL), 0.01),
        "w_gate": nrm(ks[19], (DEPTH, D_MODEL, FFN_HIDDEN), D_MODEL ** -0.5),
        "w_up": nrm(ks[20], (DEPTH, D_MODEL, FFN_HIDDEN), D_MODEL ** -0.5),
        "w_down": nrm(ks[21], (DEPTH, FFN_HIDDEN, D_MODEL), FFN_HIDDEN ** -0.5),
        "norm_ple": 1.0 + nrm(ks[22], (DEPTH, D_MODEL), 0.01),
        "w_ple_gate": nrm(ks[23], (DEPTH, D_MODEL, D_MODEL), D_MODEL ** -0.5),
        "w_ple": nrm(ks[24], (DEPTH, PLE_DIM, D_MODEL), PLE_DIM ** -0.5),
        "norm_final": 1.0 + nrm(ks[25], (D_MODEL,), 0.01),
    }


def reference(x_prompt, x_sample, cache_sb_k, cache_sb_v, cache_diff_k, cache_diff_v,
              cache_band_k, cache_band_v, p_prompt, p_sample, norm_mix, w_in_even, w_out_even,
              diff_lambda, diff_norm, w_in_odd, w_out_odd, rel_bias, norm_ffn, w_gate, w_up,
              w_down, norm_ple, w_ple_gate, w_ple, norm_final):
    pos_p = jnp.arange(x_prompt.shape[1], dtype=jnp.int32)
    pos_s = cache_sb_k.shape[2] + jnp.arange(x_sample.shape[1], dtype=jnp.int32)
    y_prompt, st_p = trunk(x_prompt, p_prompt, pos_p, None, norm_mix, w_in_even, w_out_even,
                           diff_lambda, diff_norm, w_in_odd, w_out_odd, rel_bias, norm_ffn,
                           w_gate, w_up, w_down, norm_ple, w_ple_gate, w_ple, norm_final)
    past = (cache_sb_k, cache_sb_v, cache_diff_k, cache_diff_v, cache_band_k, cache_band_v)
    y_sample, st_s = trunk(x_sample, p_sample, pos_s, past, norm_mix, w_in_even, w_out_even,
                           diff_lambda, diff_norm, w_in_odd, w_out_odd, rel_bias, norm_ffn,
                           w_gate, w_up, w_down, norm_ple, w_ple_gate, w_ple, norm_final)
    sb_k_p, sb_v_p, df_k_p, df_v_p, bd_k_p, bd_v_p = st_p
    sb_k_s, sb_v_s, df_k_s, df_v_s, bd_k_s, bd_v_s = st_s
    return (y_prompt, y_sample, sb_k_p, sb_v_p, df_k_p, df_v_p, bd_k_p, bd_v_p,
            sb_k_s, sb_v_s, df_k_s, df_v_s, bd_k_s, bd_v_s)
```

```cpp
#include <hip/hip_runtime.h>
#include <hip/hip_bf16.h>
#include <cstdio>
#include <cstdint>
#include <cmath>
__device__ __forceinline__ int lane_id_volatile() { int l; asm volatile("v_mbcnt_lo_u32_b32 %0, -1, 0\n\tv_mbcnt_hi_u32_b32 %0, -1, %0" : "=v"(l)); return l; }
namespace pg8 {
#define PG8_LAS __attribute__((address_space(3)))
typedef unsigned short bf16_t;
typedef short bf16x8 __attribute__((ext_vector_type(8)));
typedef float f32x4 __attribute__((ext_vector_type(4)));
typedef unsigned u32x4 __attribute__((ext_vector_type(4)));
constexpr int BM = 256, BK = 64, HALF = 128, HTB = HALF * BK * 2  , STAGE_BYTES = 8 * HTB, NXCD = 8, WGM = 8;

__host__ __device__ __forceinline__ int lds_byte(int r, int c) { const int st = (r >> 4) * 2 + (c >> 5), rr = r & 15, cc = c & 31, ob = rr * 64 + cc * 2; return st * 1024 + (ob ^ (((ob >> 9) & 1) << 5)); }
__host__ __device__ __forceinline__ void stage_rc(int b, int& R, int& C) { const int st = b / 1024, sb = b % 1024, swz = sb ^ (((sb >> 9) & 1) << 5); R = (st >> 1) * 16 + swz / 64; C = (st & 1) * 32 + (swz % 64) / 2; }
__host__ __device__ __forceinline__ int perm32(int rho) { const int n = rho >> 4, i = rho & 15; return 8 * (i >> 2) + 4 * n + (i & 3); }

struct Unit { int pm, pn; };
struct Gemm { const bf16_t* A; const bf16_t* Bt; int M, N, K; };

struct StaticOrder {
    int nM, nN, nwg, G, c;
    __host__ __device__ void init(int M, int N, int G_, int c_) { nM = M / BM; nN = N / BM; nwg = nM * nN; G = G_; c = c_; }
    __host__ __device__ bool next(int i, Unit& u) const {
        const int L = i * G + c; if (L >= nwg) return false;
        int wgid = L; { const int q = nwg / NXCD, r = nwg % NXCD, xcd = wgid % NXCD, off = wgid / NXCD; wgid = (xcd < r ? xcd * (q + 1) : r * (q + 1) + (xcd - r) * q) + off; }
        const int nig = WGM * nN, gid = wgid / nig, fm = gid * WGM, gsz = (nM - fm) < WGM ? (nM - fm) : WGM;
        u.pm = fm + ((wgid % nig) % gsz); u.pn = (wgid % nig) / gsz; return true;
    }
    __device__ __forceinline__ void a_ready(const Unit&) const {}
    __device__ __forceinline__ void done(const Unit&) const {}
};

__device__ __forceinline__ unsigned cvt_pk_bf16(float lo, float hi) { unsigned r; asm volatile("v_cvt_pk_bf16_f32 %0, %1, %2" : "=v"(r) : "v"(lo), "v"(hi)); return r; }
template <class Epi, class Sched, bool ALIGN_EPI = false, bool SP2 = false>
__device__ __forceinline__ void gemm_phase(PG8_LAS unsigned char* lds, const Gemm g, const Sched& S, const Epi& E, const int wave_id  ) {
    int tid_ = wave_id * 64 + lane_id_volatile(); asm volatile("" : "+v"(tid_));
    const int tid = tid_, wid = __builtin_amdgcn_readfirstlane(tid >> 6), lane = tid & 63, wr = wid >> 2, wc = wid & 3, fr = lane & 15, fq = lane >> 4;
    const int K = g.K, nt = K / BK;
    unsigned voffA[2], voffB[2];
#pragma unroll
    for (int i = 0; i < 2; ++i) { int R, C; stage_rc(tid * 16 + i * 8192, R, C); const int Rb = Epi::PERM ? ((R & ~31) + perm32(R & 31)) : R;
        voffA[i] = (unsigned)(R * K + C) * 2u; voffB[i] = (unsigned)(Rb * K + C) * 2u; }
    const size_t kstep = (size_t)(BK * 2);
    const size_t hstep = (size_t)HALF * K * 2;
    const size_t tstep = 2 * hstep;
    const unsigned ldsw = (unsigned)wid * 1024u;
    const int aoff = lds_byte(wr * 64 + fr, fq * 8), boff = lds_byte(wc * 32 + fr, fq * 8);
#define PG8_SA(b, h) (((b) * 2 + (h)) * HTB)
#define PG8_SB(b, h) ((4 + (b) * 2 + (h)) * HTB)
#define PG8_STAGE(bufoff, gbase, voff) do { _Pragma("unroll") for (int _i = 0; _i < 2; ++_i) \
        __builtin_amdgcn_global_load_lds((const unsigned*)((const char*)(gbase) + (voff)[_i]), (PG8_LAS unsigned*)(lds + (bufoff) + ldsw + _i * 8192), 16, 0, 0); } while (0)
#define PG8_LDA(dst, b, h) do { _Pragma("unroll") for (int m = 0; m < 4; ++m) _Pragma("unroll") for (int k = 0; k < 2; ++k) dst[m][k] = *(const PG8_LAS bf16x8*)(lds + PG8_SA(b, h) + aoff + m * 2048 + k * 1024); } while (0)
#define PG8_LDB(dst, b, h) do { _Pragma("unroll") for (int n = 0; n < 2; ++n) _Pragma("unroll") for (int k = 0; k < 2; ++k) dst[n][k] = *(const PG8_LAS bf16x8*)(lds + PG8_SB(b, h) + boff + n * 2048 + k * 1024); } while (0)
#define PG8_MMA(ai, bj, At, Bt) do { __builtin_amdgcn_s_setprio(1); _Pragma("unroll") for (int m = 0; m < 4; ++m) _Pragma("unroll") for (int n = 0; n < 2; ++n) _Pragma("unroll") for (int k = 0; k < 2; ++k) \
        acc[ai][bj][m][n] = __builtin_amdgcn_mfma_f32_16x16x32_bf16(Bt[n][k], At[m][k], acc[ai][bj][m][n], 0, 0, 0); __builtin_amdgcn_s_setprio(0); } while (0)
#define PG8_WAIT_V(n) asm volatile("s_waitcnt vmcnt(" #n ")" ::: "memory")
#define PG8_WAIT_L(n) asm volatile("s_waitcnt lgkmcnt(" #n ")" ::: "memory")
#define PG8_BAR __builtin_amdgcn_s_barrier()
#define PG8_SCHED __builtin_amdgcn_sched_barrier(0)
    Unit cur, nxt; int ui = 0;
    if (!S.next(0, cur)) return;
    f32x4 acc[2][2][4][2];
#pragma unroll
    for (int a = 0; a < 2; ++a)
#pragma unroll
        for (int b = 0; b < 2; ++b)
#pragma unroll
            for (int m = 0; m < 4; ++m)
#pragma unroll
                for (int n = 0; n < 2; ++n) acc[a][b][m][n] = (f32x4){0.f, 0.f, 0.f, 0.f};
    bf16x8 At[4][2], B0[2][2], B1[2][2];
    const char* cA = (const char*)g.A + (size_t)cur.pm * tstep; const char* cB = (const char*)g.Bt + (size_t)cur.pn * tstep;
    S.a_ready(cur);
    if constexpr (SP2) {
        PG8_STAGE(PG8_SB(0, 0), cB, voffB); PG8_STAGE(PG8_SB(0, 1), cB + hstep, voffB); PG8_STAGE(PG8_SA(0, 0), cA, voffA); PG8_STAGE(PG8_SA(0, 1), cA + hstep, voffA);
        if (wr == 1) PG8_BAR;
        PG8_WAIT_V(2); PG8_BAR;
        PG8_STAGE(PG8_SB(1, 0), cB + kstep, voffB); PG8_STAGE(PG8_SA(1, 0), cA + kstep, voffA); PG8_STAGE(PG8_SB(1, 1), cB + hstep + kstep, voffB);
        PG8_WAIT_V(6); PG8_BAR;
    } else {
        PG8_STAGE(PG8_SB(0, 0), cB, voffB); PG8_STAGE(PG8_SA(0, 0), cA, voffA); PG8_STAGE(PG8_SB(0, 1), cB + hstep, voffB); PG8_STAGE(PG8_SA(0, 1), cA + hstep, voffA);
        if (wr == 1) PG8_BAR;
        PG8_WAIT_V(4); PG8_BAR;
        PG8_STAGE(PG8_SB(1, 0), cB + kstep, voffB); PG8_STAGE(PG8_SA(1, 0), cA + kstep, voffA); PG8_STAGE(PG8_SB(1, 1), cB + hstep + kstep, voffB);
        PG8_WAIT_V(6); PG8_BAR;
    }
    for (;;) {
        const bool has_next = S.next(ui + 1, nxt);
        const char* nA = has_next ? (const char*)g.A + (size_t)nxt.pm * tstep : cA; const char* nB = has_next ? (const char*)g.Bt + (size_t)nxt.pn * tstep : cB;
        for (int t = 0; t < nt; t += 2) {
            const bool last = (t == nt - 2);
            const char* a1 = cA + (size_t)(t + 1) * kstep;
            const char* a2 = last ? nA : cA + (size_t)(t + 2) * kstep; const char* b2 = last ? nB : cB + (size_t)(t + 2) * kstep;
            const char* a3 = a2 + kstep; const char* b3 = b2 + kstep;
            if (last && has_next) S.a_ready(nxt);
            if constexpr (SP2) {
            PG8_LDB(B0, 0, 0); PG8_LDB(B1, 0, 1); PG8_SCHED; PG8_LDA(At, 0, 0); PG8_STAGE(PG8_SA(1, 1), a1 + hstep, voffA);
            PG8_WAIT_V(8); PG8_WAIT_L(0); PG8_BAR; PG8_MMA(0, 0, At, B0); PG8_MMA(0, 1, At, B1); PG8_BAR; PG8_SCHED;
            PG8_LDA(At, 0, 1); PG8_STAGE(PG8_SB(0, 0), b2, voffB); PG8_STAGE(PG8_SB(0, 1), b2 + hstep, voffB); PG8_STAGE(PG8_SA(0, 0), a2, voffA);
            PG8_WAIT_V(8); PG8_WAIT_L(0); PG8_BAR; PG8_MMA(1, 0, At, B0); PG8_MMA(1, 1, At, B1); PG8_BAR; PG8_SCHED;
            PG8_LDB(B0, 1, 0); PG8_LDB(B1, 1, 1); PG8_SCHED; PG8_LDA(At, 1, 0); PG8_STAGE(PG8_SA(0, 1), a2 + hstep, voffA);
            PG8_WAIT_V(8); PG8_WAIT_L(0); PG8_BAR; PG8_MMA(0, 0, At, B0); PG8_MMA(0, 1, At, B1); PG8_BAR; PG8_SCHED;
            PG8_LDA(At, 1, 1); PG8_STAGE(PG8_SB(1, 0), b3, voffB); PG8_STAGE(PG8_SB(1, 1), b3 + hstep, voffB); PG8_STAGE(PG8_SA(1, 0), a3, voffA);
            PG8_WAIT_V(8); PG8_WAIT_L(0); PG8_BAR; PG8_MMA(1, 0, At, B0); PG8_MMA(1, 1, At, B1); PG8_BAR; PG8_SCHED;
            } else {
            PG8_LDB(B0, 0, 0); PG8_SCHED; PG8_LDA(At, 0, 0); PG8_STAGE(PG8_SA(1, 1), a1 + hstep, voffA);
            PG8_WAIT_L(8); PG8_BAR; PG8_WAIT_L(0); PG8_MMA(0, 0, At, B0); PG8_BAR; PG8_SCHED;
            PG8_LDB(B1, 0, 1); PG8_STAGE(PG8_SB(0, 0), b2, voffB);
            PG8_BAR; PG8_WAIT_L(0); PG8_MMA(0, 1, At, B1); PG8_BAR;
            PG8_LDA(At, 0, 1); PG8_STAGE(PG8_SA(0, 0), a2, voffA);
            PG8_BAR; PG8_WAIT_L(0); PG8_MMA(1, 0, At, B0); PG8_BAR; PG8_SCHED;
            PG8_STAGE(PG8_SB(0, 1), b2 + hstep, voffB);
            PG8_WAIT_V(6); PG8_BAR; PG8_MMA(1, 1, At, B1); PG8_BAR;
            PG8_LDB(B0, 1, 0); PG8_SCHED; PG8_LDA(At, 1, 0); PG8_STAGE(PG8_SA(0, 1), a2 + hstep, voffA);
            PG8_WAIT_L(8); PG8_BAR; PG8_WAIT_L(0); PG8_MMA(0, 0, At, B0); PG8_BAR; PG8_SCHED;
            PG8_LDB(B1, 1, 1); PG8_STAGE(PG8_SB(1, 0), b3, voffB);
            PG8_BAR; PG8_WAIT_L(0); PG8_MMA(0, 1, At, B1); PG8_BAR;
            PG8_LDA(At, 1, 1); PG8_STAGE(PG8_SA(1, 0), a3, voffA);
            PG8_BAR; PG8_WAIT_L(0); PG8_MMA(1, 0, At, B0); PG8_BAR; PG8_SCHED;
            PG8_STAGE(PG8_SB(1, 1), b3 + hstep, voffB);
            PG8_WAIT_V(6); PG8_BAR; PG8_MMA(1, 1, At, B1); PG8_BAR;
            }
        }
        if constexpr (ALIGN_EPI) { if (wr == 0) PG8_BAR; }
        if constexpr (!Epi::AFTER_DRAIN) { E(acc, cur, wr, wc, fr, fq); S.done(cur); }
        if (!has_next) break;
#pragma unroll
        for (int a = 0; a < 2; ++a)
#pragma unroll
            for (int b = 0; b < 2; ++b)
#pragma unroll
                for (int m = 0; m < 4; ++m)
#pragma unroll
                    for (int n = 0; n < 2; ++n) acc[a][b][m][n] = (f32x4){0.f, 0.f, 0.f, 0.f};
        cur = nxt; cA = nA; cB = nB; ++ui;
        if constexpr (ALIGN_EPI) { if (wr == 1) PG8_BAR; }
    }
    PG8_WAIT_V(0);
    if constexpr (!ALIGN_EPI) { if (wr == 0) PG8_BAR; }
    PG8_BAR;
    if constexpr (Epi::AFTER_DRAIN) { E.fused(acc, cur, wr, wc, fr, fq, lds, wid, lane); S.done(cur); }
#undef PG8_SA
#undef PG8_SB
#undef PG8_STAGE
#undef PG8_LDA
#undef PG8_LDB
#undef PG8_MMA
#undef PG8_WAIT_V
#undef PG8_WAIT_L
#undef PG8_BAR
#undef PG8_SCHED
}
}
#define LAS __attribute__((address_space(3)))
#define GAS __attribute__((address_space(1)))
typedef unsigned short bf16_t;
typedef short bf16x8 __attribute__((ext_vector_type(8)));
typedef short s16x4 __attribute__((ext_vector_type(4)));
typedef float f32x4 __attribute__((ext_vector_type(4)));
typedef float f32x16 __attribute__((ext_vector_type(16)));
typedef unsigned u32x4 __attribute__((ext_vector_type(4)));
typedef unsigned u32x2 __attribute__((ext_vector_type(2)));
typedef float f32x2_t __attribute__((ext_vector_type(2)));
typedef __bf16 bf16x2_t __attribute__((ext_vector_type(2)));

constexpr int D = 1024, MP = 32768, MS = 1024, MT = MP + MS, SEQ = 8192, NLAYER = 4;
constexpr int FFN = 2816, NGU = 2 * FFN, PLE = 256, NQKV = 3072;
constexpr float EPS = 1e-6f;
constexpr float LOG2E = 1.4426950408889634f;
constexpr float C2 = 0.125f * LOG2E;

constexpr size_t O_YP = 0, O_YS = O_YP + (size_t)MP * D, O_SBKP = O_YS + (size_t)MS * D, O_SBVP = O_SBKP + 2ull * MP * 512, O_DFKP = O_SBVP + 2ull * MP * 512,
                 O_DFVP = O_DFKP + 2ull * MP * 512, O_BDKP = O_DFVP + 2ull * MP * 512, O_BDVP = O_BDKP + 2ull * 4 * 512 * 1024, O_SBKS = O_BDVP + 2ull * 4 * 512 * 1024,
                 O_SBVS = O_SBKS + 2ull * MS * 512, O_DFKS = O_SBVS + 2ull * MS * 512, O_DFVS = O_DFKS + 2ull * MS * 512, O_BDKS = O_DFVS + 2ull * MS * 512,
                 O_BDVS = O_BDKS + 2ull * MS * 1024, O_END = O_BDVS + 2ull * MS * 1024;
static_assert(O_END == 185597952ull, "output size");

constexpr size_t MiB = 1u << 20;
constexpr size_t WS_CTL = 0, CTL_ZERO_BYTES = 5 * MiB;
constexpr int CW_BAR = 4096;
constexpr int CW_QUEUE = 8192;
constexpr int CW_CHAIN = 16384;
constexpr size_t WS_SS = 1 * MiB;
static_assert(WS_SS + 13ull * MT * 8 <= CTL_ZERO_BYTES, "ss inside memset region");
typedef unsigned long long ss_t;
constexpr float SS_SCALE = 1048576.0f, SS_INV = 1.0f / 1048576.0f;
__device__ __forceinline__ float ss_rs(const ss_t* ss, int r);
constexpr size_t WS_ROPEC = 5 * MiB, WS_ROPES = 6 * MiB, WS_LAM = 7 * MiB;
constexpr size_t WS_W = 8 * MiB, W_LAYER = 27 * MiB;
constexpr size_t WO_IN = 0, WO_OUT = WO_IN + (size_t)NQKV * D * 2, WO_GU = WO_OUT + (size_t)D * D * 2, WO_DN = WO_GU + (size_t)NGU * D * 2, WO_PG = WO_DN + (size_t)D * FFN * 2,
                 WO_PL = WO_PG + (size_t)D * D * 2, WO_END = WO_PL + (size_t)D * PLE * 2;
static_assert(WO_END == W_LAYER, "weights per layer");
constexpr size_t WS_H = 116 * MiB;
constexpr size_t WS_HB = 248 * MiB;
constexpr size_t WS_QKV = 314 * MiB;
constexpr size_t WS_O = 512 * MiB;
constexpr size_t WS_PL = 578 * MiB;
constexpr size_t WS_PB = 644 * MiB;
constexpr size_t WS_HB2 = 710 * MiB;
constexpr size_t WS_ACT = 776 * MiB;
constexpr size_t WS_END = 958 * MiB;
static_assert(WS_W + 4 * W_LAYER <= WS_H && WS_H + (size_t)MT * D * 4 <= WS_HB && WS_HB + (size_t)MT * D * 2 <= WS_QKV && WS_QKV + (size_t)MT * NQKV * 2 <= WS_O &&
              WS_O + (size_t)MT * D * 2 <= WS_PL && WS_PL + (size_t)MT * D * 2 <= WS_PB && WS_PB + 4ull * MT * PLE * 2 <= WS_HB2 && WS_HB2 + (size_t)MT * D * 2 <= WS_ACT && WS_ACT + (size_t)MT * FFN * 2 <= WS_END, "ws map");

constexpr int ATT_BIAS_OFF = 139264, LDSCTL_OFF = 147456, LDS_BYTES = 147456 + 512;
constexpr int NWAVES = 8, NTHREADS = 512;

#define LDS_WAIT() asm volatile("s_waitcnt lgkmcnt(0)" ::: "memory")
#define VM_WAIT() asm volatile("s_waitcnt vmcnt(0)" ::: "memory")

__device__ __forceinline__ unsigned cvtpk(float lo, float hi) { f32x2_t v = {lo, hi}; bf16x2_t b = __builtin_convertvector(v, bf16x2_t); return __builtin_bit_cast(unsigned, b); }
__device__ __forceinline__ float ss_rs(const ss_t* ss, int r) { return rsqrtf((float)ss[r] * (SS_INV / D) + EPS); }
__device__ __forceinline__ void ss_add(ss_t* ss, int r, float ps) { atomicAdd(ss + r, (ss_t)__float2ull_rn(ps * SS_SCALE)); }
__device__ __forceinline__ void st16(void* p, u32x4 v, bool wt) { if (wt) asm volatile("global_store_dwordx4 %0, %1, off sc1\n\ts_nop 2" :: "v"(p), "v"(v) : "memory");     else *(u32x4*)p = v; }
__device__ __forceinline__ void st8(void* p, u32x2 v, bool wt) { if (wt) asm volatile("global_store_dwordx2 %0, %1, off sc1\n\ts_nop 2" :: "v"(p), "v"(v) : "memory"); else *(u32x2*)p = v; }
__device__ __forceinline__ float bf_lo(unsigned w) { return __uint_as_float(w << 16); }
__device__ __forceinline__ float bf_hi(unsigned w) { return __uint_as_float(w & 0xffff0000u); }
__device__ __forceinline__ u32x4 pack8(f32x4 a, f32x4 b) { u32x4 w; w.x = cvtpk(a[0], a[1]); w.y = cvtpk(a[2], a[3]); w.z = cvtpk(b[0], b[1]); w.w = cvtpk(b[2], b[3]); return w; }
__device__ __forceinline__ float sum_x16_x32(float v) {
    auto a = __builtin_amdgcn_permlane16_swap(__float_as_uint(v), __float_as_uint(v), false, false); v = __uint_as_float(a[0]) + __uint_as_float(a[1]);
    auto b = __builtin_amdgcn_permlane32_swap(__float_as_uint(v), __float_as_uint(v), false, false); return __uint_as_float(b[0]) + __uint_as_float(b[1]);
}
__device__ __forceinline__ float wave_sum(float v) {
#pragma unroll
    for (int o = 1; o < 64; o <<= 1) v += __shfl_xor(v, o);
    return v;
}

#ifndef H_BF16
#define H_BF16 1
#endif
using pg8::Unit;
#define UNI(x) __builtin_amdgcn_readfirstlane(x)
template <bool WT> struct RQkvEvenT {
    static constexpr bool NEED_RS = true, NEED_SS = false;
    bf16_t* qkv; const ss_t* ss; const float* ropec; const float* ropes; float* out; int e; ss_t* ssn; bool wt;
    __device__ __forceinline__ float rs_of(int r) const { return ss_rs(ss, r); }
    static constexpr int PFM = 1;
    struct Pre { f32x4 cs, sn; };
    __device__ __forceinline__ Pre pre(int r, int c) const {
        Pre p; const int region = UNI(c >> 9), cl = c & 511;
        if (region == 3 || region == 4) { const bool sample = UNI(r >= MP); const int pos = sample ? 1024 + (r & 31) : (r & (SEQ - 1)); const int i0 = 16 * ((cl >> 5) & 1) + 4 * ((cl >> 3) & 3);
            p.cs = *(const f32x4*)(ropec + pos * 32 + i0); p.sn = *(const f32x4*)(ropes + pos * 32 + i0); }
        return p; }
    __device__ __forceinline__ float row8(int r, int c, const f32x4 a0, const f32x4 a1, float rs) const { return row8(r, c, a0, a1, rs, pre(r, c)); }
    __device__ __forceinline__ float row8(int r, int c, const f32x4 a0, const f32x4 a1, float rs, const Pre& pr) const {
        const int region = UNI(c >> 9), cl = c & 511;
        const bool sample = UNI(r >= MP);
        float* ob = nullptr;
        if (region == 1) ob = out + (sample ? O_SBKS + (size_t)e * MS * 512 : O_SBKP + (size_t)e * MP * 512);
        else if (region == 2) ob = out + (sample ? O_SBVS + (size_t)e * MS * 512 : O_SBVP + (size_t)e * MP * 512);
        else if (region == 4) ob = out + (sample ? O_DFKS + (size_t)e * MS * 512 : O_DFKP + (size_t)e * MP * 512);
        else if (region == 5) ob = out + (sample ? O_DFVS + (size_t)e * MS * 512 : O_DFVP + (size_t)e * MP * 512);
        const float qs = (region == 0 || region == 3) ? C2 : 1.0f;
        const int tok = sample ? r - MP : r;
        bf16_t* qrow = qkv + (size_t)r * NQKV + region * 512;
        if (region == 3 || region == 4) {
            const int pos = sample ? 1024 + (r & 31) : (r & (SEQ - 1));
            const int i0 = 16 * ((cl >> 5) & 1) + 4 * ((cl >> 3) & 3), lc = (cl & ~63) + i0;
            const f32x4 cs = pr.cs, sn = pr.sn; (void)pos;
            const f32x4 x1 = a0 * rs, x2 = a1 * rs;
            const f32x4 o1 = x1 * cs - x2 * sn, o2 = x2 * cs + x1 * sn;
            u32x2 w1, w2; w1.x = cvtpk(o1[0] * qs, o1[1] * qs); w1.y = cvtpk(o1[2] * qs, o1[3] * qs); w2.x = cvtpk(o2[0] * qs, o2[1] * qs); w2.y = cvtpk(o2[2] * qs, o2[3] * qs);
            st8(qrow + lc, w1, WT); st8(qrow + lc + 32, w2, WT);
            if (ob) { float* op = ob + (size_t)tok * 512 + lc; __builtin_nontemporal_store(o1, (f32x4*)op); __builtin_nontemporal_store(o2, (f32x4*)(op + 32)); }
        } else {
            const f32x4 v0 = a0 * rs, v1 = a1 * rs;
            st16(qrow + cl, pack8(v0 * qs, v1 * qs), WT);
            if (ob) { float* op = ob + (size_t)tok * 512 + cl; __builtin_nontemporal_store(v0, (f32x4*)op); __builtin_nontemporal_store(v1, (f32x4*)(op + 4)); }
        }
        return 0.f;
    }
};
template <bool WT> struct RQkvOddT {
    static constexpr bool NEED_RS = true, NEED_SS = false;
    bf16_t* qkv; const ss_t* ss; float* out; int od; ss_t* ssn; bool wt;
    __device__ __forceinline__ float rs_of(int r) const { return ss_rs(ss, r); }
    static constexpr int PFM = 4; struct Pre {}; __device__ __forceinline__ Pre pre(int, int) const { return Pre{}; }
    __device__ __forceinline__ float row8(int r, int c, const f32x4 a0, const f32x4 a1, float rs, const Pre&) const { return row8(r, c, a0, a1, rs); }
    __device__ __forceinline__ float row8(int r, int c, const f32x4 a0, const f32x4 a1, float rs) const {
        const int region = UNI(c >> 10), cl = c & 1023;
        const bool sample = UNI(r >= MP);
        const bool keep = sample || UNI((r & (SEQ - 1)) >= 7680);
        float* ob = nullptr;
        if (keep && region == 1) ob = out + (sample ? O_BDKS + (size_t)od * MS * 1024 : O_BDKP + (size_t)od * 4 * 512 * 1024);
        else if (keep && region == 2) ob = out + (sample ? O_BDVS + (size_t)od * MS * 1024 : O_BDVP + (size_t)od * 4 * 512 * 1024);
        const float qs = (region == 0) ? C2 : 1.0f;
        const int tok = sample ? r - MP : (r >> 13) * 512 + ((r & (SEQ - 1)) - 7680);
        const f32x4 v0 = a0 * rs, v1 = a1 * rs;
        st16(qkv + (size_t)r * NQKV + region * 1024 + cl, pack8(v0 * qs, v1 * qs), WT);
        if (ob) { float* op = ob + (size_t)tok * 1024 + cl; __builtin_nontemporal_store(v0, (f32x4*)op); __builtin_nontemporal_store(v1, (f32x4*)(op + 4)); }
        return 0.f;
    }
};
__device__ __forceinline__ float sumsq8(const f32x4 v0, const f32x4 v1) { return (v0[0] * v0[0] + v0[1] * v0[1]) + (v0[2] * v0[2] + v0[3] * v0[3]) + (v1[0] * v1[0] + v1[1] * v1[1]) + (v1[2] * v1[2] + v1[3] * v1[3]); }
template <bool WT> struct RResidT {
    static constexpr bool NEED_RS = false, NEED_SS = true;
    const float* resP; const float* resS; const bf16_t* resB; float* h; bf16_t* hb; ss_t* ssn; bool wt;
    __device__ __forceinline__ float rs_of(int) const { return 1.0f; }
    static constexpr int PFM = 4;
    struct Pre { u32x4 a; };
    __device__ __forceinline__ Pre pre(int r, int c) const {
        Pre p; p.a = *(const u32x4*)(resB + (size_t)r * D + c); return p; }
    __device__ __forceinline__ float row8(int r, int c, const f32x4 a0, const f32x4 a1, float rs) const { return row8(r, c, a0, a1, rs, pre(r, c)); }
    __device__ __forceinline__ float row8(int r, int c, const f32x4 a0, const f32x4 a1, float, const Pre& pr) const {
        f32x4 v0, v1;
        { const u32x4 w = pr.a; v0 = a0 + (f32x4){bf_lo(w.x), bf_hi(w.x), bf_lo(w.y), bf_hi(w.y)}; v1 = a1 + (f32x4){bf_lo(w.z), bf_hi(w.z), bf_lo(w.w), bf_hi(w.w)}; }
        if (!H_BF16 && h) { *(f32x4*)(h + (size_t)r * D + c) = v0; *(f32x4*)(h + (size_t)r * D + c + 4) = v1; }
        st16(hb + (size_t)r * D + c, pack8(v0, v1), WT);
        return sumsq8(v0, v1);
    }
};
template <bool WT> struct RGateUpT {
    static constexpr bool NEED_RS = true, NEED_SS = false;
    bf16_t* act; const ss_t* ss; ss_t* ssn; bool wt;
    __device__ __forceinline__ float rs_of(int r) const { return ss_rs(ss, r); }
    static constexpr int PFM = 4; struct Pre {}; __device__ __forceinline__ Pre pre(int, int) const { return Pre{}; }
    __device__ __forceinline__ float row8(int r, int c, const f32x4 a0, const f32x4 a1, float rs, const Pre&) const { return row8(r, c, a0, a1, rs); }
    __device__ __forceinline__ float row8(int r, int c, const f32x4 a0, const f32x4 a1, float rs) const {
        const f32x4 g = a0 * rs, up = a1 * rs;
        float a[4];
#pragma unroll
        for (int j = 0; j < 4; ++j) a[j] = g[j] * __builtin_amdgcn_rcpf(1.0f + __builtin_amdgcn_exp2f(-g[j] * LOG2E)) * up[j];
        u32x2 w; w.x = cvtpk(a[0], a[1]); w.y = cvtpk(a[2], a[3]);
        st8(act + (size_t)r * FFN + (c >> 1), w, WT);
        return 0.f;
    }
};
template <bool WT> struct RPlT {
    static constexpr bool NEED_RS = false, NEED_SS = false;
    bf16_t* pl; ss_t* ssn; bool wt;
    __device__ __forceinline__ float rs_of(int) const { return 1.0f; }
    static constexpr int PFM = 4; struct Pre {}; __device__ __forceinline__ Pre pre(int, int) const { return Pre{}; }
    __device__ __forceinline__ float row8(int r, int c, const f32x4 a0, const f32x4 a1, float rs, const Pre&) const { return row8(r, c, a0, a1, rs); }
    __device__ __forceinline__ float row8(int r, int c, const f32x4 a0, const f32x4 a1, float) const { st16(pl + (size_t)r * D + c, pack8(a0, a1), WT); return 0.f; }
};
template <bool WT> struct RPleGateT {
    static constexpr bool NEED_RS = true, NEED_SS = true;
    const bf16_t* pl; const ss_t* ss; float* h; const bf16_t* hbin; bf16_t* hb; ss_t* ssn; bool wt;
    __device__ __forceinline__ float rs_of(int r) const { return ss_rs(ss, r); }
    static constexpr int PFM = 2;
    struct Pre { u32x4 pw, hw; };
    __device__ __forceinline__ Pre pre(int r, int c) const { Pre p; p.pw = *(const u32x4*)(pl + (size_t)r * D + c); p.hw = *(const u32x4*)(hbin + (size_t)r * D + c); return p; }
    __device__ __forceinline__ float row8(int r, int c, const f32x4 a0, const f32x4 a1, float rs) const { return row8(r, c, a0, a1, rs, pre(r, c)); }
    __device__ __forceinline__ float row8(int r, int c, const f32x4 a0, const f32x4 a1, float rs, const Pre& pr) const {
        u32x4 wo; float ps = 0.f;
#pragma unroll
        for (int hf_ = 0; hf_ < 2; ++hf_) {
            const f32x4 a = hf_ ? a1 : a0;
            const u32x2 pw = hf_ ? (u32x2){pr.pw.z, pr.pw.w} : (u32x2){pr.pw.x, pr.pw.y};
            f32x4 v;
            if (!H_BF16 && h) v = *(const f32x4*)(h + (size_t)r * D + c + 4 * hf_);
            else { const u32x2 w = hf_ ? (u32x2){pr.hw.z, pr.hw.w} : (u32x2){pr.hw.x, pr.hw.y}; v = (f32x4){bf_lo(w.x), bf_hi(w.x), bf_lo(w.y), bf_hi(w.y)}; }
            const f32x4 p = {bf_lo(pw.x), bf_hi(pw.x), bf_lo(pw.y), bf_hi(pw.y)};
#pragma unroll
            for (int j = 0; j < 4; ++j) v[j] += p[j] * __builtin_amdgcn_rcpf(1.0f + __builtin_amdgcn_exp2f(-a[j] * rs * LOG2E));
            if (!H_BF16 && h) *(f32x4*)(h + (size_t)r * D + c + 4 * hf_) = v;
            ps += (v[0] * v[0] + v[1] * v[1]) + (v[2] * v[2] + v[3] * v[3]);
            if (hf_) { wo.z = cvtpk(v[0], v[1]); wo.w = cvtpk(v[2], v[3]); } else { wo.x = cvtpk(v[0], v[1]); wo.y = cvtpk(v[2], v[3]); }
        }
        st16(hb + (size_t)r * D + c, wo, WT);
        return ps;
    }
};
using RQkvEven = RQkvEvenT<false>;
using RQkvOdd = RQkvOddT<false>;
using RResid = RResidT<false>;
using RGateUp = RGateUpT<false>;
using RPl = RPlT<false>;
using RPleGate = RPleGateT<false>;
template <class RE, bool HOIST = false> struct BigEpi {
    static constexpr bool PERM = true, AFTER_DRAIN = false;
    RE e;
    __device__ __forceinline__ void operator()(const f32x4 (&acc)[2][2][4][2], const Unit& u, int wr, int wc, int fr, int fq) const {
        { const int l_ = lane_id_volatile(); fr = l_ & 15; fq = l_ >> 4; }
        const int row0 = u.pm * 256 + wr * 64 + fr;
        if (!HOIST) {
#pragma unroll
            for (int ai = 0; ai < 2; ++ai)
#pragma unroll
                for (int m = 0; m < 4; ++m) {
                    const int r = row0 + ai * 128 + m * 16;
                    const float rs = RE::NEED_RS ? e.rs_of(r) : 1.0f;
                    float ps = 0.f;
#pragma unroll
                    for (int bj = 0; bj < 2; ++bj) ps += e.row8(r, u.pn * 256 + bj * 128 + wc * 32 + 8 * fq, acc[ai][bj][m][0], acc[ai][bj][m][1], rs);
                    if (RE::NEED_SS) { ps = sum_x16_x32(ps); if (fq == 0 && e.ssn) ss_add(e.ssn, r, ps); }
                }
            return;
        }
        float rsv[2][4];
#pragma unroll
        for (int ai = 0; ai < 2; ++ai)
#pragma unroll
            for (int m = 0; m < 4; ++m) rsv[ai][m] = RE::NEED_RS ? e.rs_of(row0 + ai * 128 + m * 16) : 1.0f;
        constexpr int PFM = RE::PFM;
#pragma unroll
        for (int ai = 0; ai < 2; ++ai)
#pragma unroll
          for (int m0 = 0; m0 < 4; m0 += PFM) {
            typename RE::Pre pre[PFM][2];
#pragma unroll
            for (int m = 0; m < PFM; ++m)
#pragma unroll
                for (int bj = 0; bj < 2; ++bj) pre[m][bj] = e.pre(row0 + ai * 128 + (m0 + m) * 16, u.pn * 256 + bj * 128 + wc * 32 + 8 * fq);
#pragma unroll
            for (int m = m0; m < m0 + PFM; ++m) {
                const int r = row0 + ai * 128 + m * 16;
                float ps = 0.f;
#pragma unroll
                for (int bj = 0; bj < 2; ++bj) ps += e.row8(r, u.pn * 256 + bj * 128 + wc * 32 + 8 * fq, acc[ai][bj][m][0], acc[ai][bj][m][1], rsv[ai][m], pre[m - m0][bj]);
                if (RE::NEED_SS) { ps = sum_x16_x32(ps); if (fq == 0 && e.ssn) ss_add(e.ssn, r, ps); }
            }
          }
    }
};
struct RAny {
    static constexpr bool NEED_RS = true, NEED_SS = true;
    int kind;
    int L;
    unsigned char* ws; float* out; const float* x_sample; ss_t* ssn;
    __device__ __forceinline__ const ss_t* ssp(int k) const { return (const ss_t*)(ws + WS_SS) + (size_t)(3 * L + k) * MT; }
    __device__ __forceinline__ float rs_of(int r) const {
        if (kind <= 1) return ss_rs(ssp(0), r);
        if (kind == 3) return ss_rs(ssp(1), r);
        if (kind == 6) return ss_rs(ssp(2), r);
        return 1.0f;
    }
    __device__ __forceinline__ float row8(int r, int c, const f32x4 a0, const f32x4 a1, float rs) const {
        bf16_t* hb = (bf16_t*)(ws + WS_HB); bf16_t* hb2 = (bf16_t*)(ws + WS_HB2); bf16_t* plb = (bf16_t*)(ws + WS_PL);
        switch (kind) {
            case 0: { const RQkvEvenT<true> q{(bf16_t*)(ws + WS_QKV), ssp(0), (const float*)(ws + WS_ROPEC), (const float*)(ws + WS_ROPES), out, L >> 1, nullptr, true}; return q.row8(r, c, a0, a1, rs); }
            case 1: { const RQkvOddT<true> q{(bf16_t*)(ws + WS_QKV), ssp(0), out, L >> 1, nullptr, true}; return q.row8(r, c, a0, a1, rs); }
            case 2: { const RResidT<true> q{nullptr, x_sample, hb2, nullptr, hb, nullptr, true}; return q.row8(r, c, a0, a1, rs); }
            case 3: { const RGateUpT<true> q{(bf16_t*)(ws + WS_ACT), ssp(1), nullptr, true}; return q.row8(r, c, a0, a1, rs); }
            case 4: { const RResidT<true> q{nullptr, nullptr, hb, nullptr, hb, nullptr, true}; return q.row8(r, c, a0, a1, rs); }
            case 5: { const RPlT<true> q{plb, nullptr, true}; return q.row8(r, c, a0, a1, rs); }
            default: { const RPleGateT<true> q{plb, ssp(2), nullptr, hb, hb2, nullptr, true}; return q.row8(r, c, a0, a1, rs); }
        }
    }
};
struct AnyEpi {
    static constexpr bool PERM = true, AFTER_DRAIN = false;
    int kind, L; unsigned char* ws; float* out; const float* x_sample; ss_t* ssn;
    __device__ __forceinline__ const ss_t* ssp(int k) const { return (const ss_t*)(ws + WS_SS) + (size_t)(3 * L + k) * MT; }
    __device__ __forceinline__ void operator()(const f32x4 (&acc)[2][2][4][2], const Unit& u, int wr, int wc, int fr, int fq) const {
        bf16_t* hb = (bf16_t*)(ws + WS_HB); bf16_t* hb2 = (bf16_t*)(ws + WS_HB2); bf16_t* plb = (bf16_t*)(ws + WS_PL);
        switch (kind) {
            case 0: { const BigEpi<RQkvEvenT<true>, true> q{{(bf16_t*)(ws + WS_QKV), ssp(0), (const float*)(ws + WS_ROPEC), (const float*)(ws + WS_ROPES), out, L >> 1, nullptr, true}}; q(acc, u, wr, wc, fr, fq); break; }
            case 1: { const BigEpi<RQkvOddT<true>, true> q{{(bf16_t*)(ws + WS_QKV), ssp(0), out, L >> 1, nullptr, true}}; q(acc, u, wr, wc, fr, fq); break; }
            case 2: { const BigEpi<RResidT<true>, true> q{{nullptr, x_sample, hb2, nullptr, hb, ssn, true}}; q(acc, u, wr, wc, fr, fq); break; }
            case 3: { const BigEpi<RGateUpT<true>, true> q{{(bf16_t*)(ws + WS_ACT), ssp(1), nullptr, true}}; q(acc, u, wr, wc, fr, fq); break; }
            case 4: { const BigEpi<RResidT<true>, true> q{{nullptr, nullptr, hb, nullptr, hb, ssn, true}}; q(acc, u, wr, wc, fr, fq); break; }
            case 5: { const BigEpi<RPlT<true>, true> q{{plb, nullptr, true}}; q(acc, u, wr, wc, fr, fq); break; }
            default: { const BigEpi<RPleGateT<true>, true> q{{plb, ssp(2), nullptr, hb, hb2, ssn, true}}; q(acc, u, wr, wc, fr, fq); break; }
        }
    }
};
namespace pg8 {
struct OneUnit {
    Unit u;
    __device__ __forceinline__ bool next(int i, Unit& o) const { if (i) return false; o = u; return true; }
    __device__ __forceinline__ void a_ready(const Unit&) const {}
    __device__ __forceinline__ void done(const Unit&) const {}
};
}
template <class RE> __device__ __forceinline__ void small_gemm(const bf16_t* A, const bf16_t* Bt, int N, int K, const RE& e, int wave, int G) {
    const int lane = lane_id_volatile(), fr = lane & 15, fq = lane >> 4, w4 = wave >> 1, w2 = wave & 1;
    const int nunit = 16 * (N / 64);
    for (int u = blockIdx.x; u < nunit; u += G) {
        const int rt = u & 15, ct = u >> 4;
        const int r = MP + 64 * rt + 16 * w4 + fr, c = 64 * ct + 32 * w2 + 8 * fq;
        const bf16_t* ap = A + (size_t)r * K + 8 * fq;
        const bf16_t* bp0 = Bt + (size_t)(64 * ct + 32 * w2 + 8 * (fr >> 2) + (fr & 3)) * K + 8 * fq;
        const bf16_t* bp1 = bp0 + (size_t)4 * K;
        f32x4 c0 = {0.f, 0.f, 0.f, 0.f}, c1 = {0.f, 0.f, 0.f, 0.f};
        for (int k0 = 0; k0 < K; k0 += 256) {
            bf16x8 av[8], b0v[8], b1v[8];
#pragma unroll
            for (int i = 0; i < 8; ++i) { av[i] = *(const bf16x8*)(ap + k0 + 32 * i); b0v[i] = *(const bf16x8*)(bp0 + k0 + 32 * i); b1v[i] = *(const bf16x8*)(bp1 + k0 + 32 * i); }
#pragma unroll
            for (int i = 0; i < 8; ++i) { c0 = __builtin_amdgcn_mfma_f32_16x16x32_bf16(b0v[i], av[i], c0, 0, 0, 0); c1 = __builtin_amdgcn_mfma_f32_16x16x32_bf16(b1v[i], av[i], c1, 0, 0, 0); }
        }
        const float rs = RE::NEED_RS ? e.rs_of(r) : 1.0f;
        float ps = e.row8(r, c, c0, c1, rs);
        if (RE::NEED_SS) { ps = sum_x16_x32(ps); if (fq == 0) ss_add(e.ssn, r, ps); }
    }
    asm volatile("s_waitcnt vmcnt(0)" ::: "memory");
}
namespace att {
constexpr int KSUB = 64 * 144, VSUB = 8192;
enum { SB = 0, DIFF = 1, BAND = 2 };
template <int MODE> struct Geo;
template <> struct Geo<SB>   { static constexpr int NKS = 1, NVS = 1, NDB = 2; };
template <> struct Geo<DIFF> { static constexpr int NKS = 2, NVS = 2, NDB = 4; };
template <> struct Geo<BAND> { static constexpr int NKS = 4, NVS = 4, NDB = 2; };

struct Params {
    const bf16_t* qkv; bf16_t* o;
    const float* cK; const float* cV;
    const float* gain;
    const float* bias;
    const float* lamp;
};
struct TileSrc { const void* k; const void* v; int pitch; int f32; int nvalid; };

__device__ __forceinline__ int kpi(int m) { return ((m >> 2) & 1) * 16 + (m >> 3) * 4 + (m & 3); }
__device__ __forceinline__ s16x4 vtr(const LAS char* p) { typedef short v4i16_t __attribute__((ext_vector_type(4))); return __builtin_bit_cast(s16x4, __builtin_amdgcn_ds_read_tr16_b64_v4i16((LAS v4i16_t*)p)); }
__device__ __forceinline__ float swap_lo(float x, float& hi_out) { auto rr = __builtin_amdgcn_permlane32_swap(__float_as_uint(x), __float_as_uint(x), false, false); hi_out = __uint_as_float(rr[1]); return __uint_as_float(rr[0]); }

template <int NKS, int NVS> __device__ __forceinline__ void tile_load(u32x4 (&kr)[NKS], u32x4 (&vr)[NVS], const TileSrc& s, int key, int ch) {
    const bool ok = key < s.nvalid;
    const u32x4 z = {0u, 0u, 0u, 0u};
    if (s.f32) {
        const float* kp = (const float*)s.k + (size_t)key * s.pitch + ch * 8;
        const float* vp = (const float*)s.v + (size_t)key * s.pitch + ch * 8;
        f32x4 ta[NKS][2], tb[NVS][2];
#pragma unroll
        for (int i = 0; i < NKS; ++i) { ta[i][0] = *(const f32x4*)(kp + i * 64); ta[i][1] = *(const f32x4*)(kp + i * 64 + 4); }
#pragma unroll
        for (int i = 0; i < NVS; ++i) { tb[i][0] = *(const f32x4*)(vp + i * 64); tb[i][1] = *(const f32x4*)(vp + i * 64 + 4); }
#pragma unroll
        for (int i = 0; i < NKS; ++i) kr[i] = pack8(ta[i][0], ta[i][1]);
#pragma unroll
        for (int i = 0; i < NVS; ++i) vr[i] = pack8(tb[i][0], tb[i][1]);
    } else {
        const bf16_t* kp = (const bf16_t*)s.k + (size_t)key * s.pitch + ch * 8;
        const bf16_t* vp = (const bf16_t*)s.v + (size_t)key * s.pitch + ch * 8;
#pragma unroll
        for (int i = 0; i < NKS; ++i) kr[i] = ok ? *(const u32x4*)(kp + i * 64) : z;
#pragma unroll
        for (int i = 0; i < NVS; ++i) vr[i] = ok ? *(const u32x4*)(vp + i * 64) : z;
    }
}
template <int NKS, int NVS> __device__ __forceinline__ void tile_store(LAS char* buf, const u32x4 (&kr)[NKS], const u32x4 (&vr)[NVS], int key, int ch) {
#pragma unroll
    for (int i = 0; i < NKS; ++i) *(LAS u32x4*)(buf + i * KSUB + key * 144 + ch * 16) = kr[i];
#pragma unroll
    for (int i = 0; i < NVS; ++i) *(LAS u32x4*)(buf + NKS * KSUB + i * VSUB + ((key >> 3) * 2 + (ch >> 2)) * 512 + (key & 7) * 64 + (ch & 3) * 16) = vr[i];
}
__device__ __forceinline__ void qk(f32x16 (&p)[2], const LAS char* ksub, const bf16x8 (&qf)[4], int kbase, float cinit) {
#pragma unroll
    for (int kb = 0; kb < 2; ++kb) {
        f32x16 c;
#pragma unroll
        for (int r = 0; r < 16; ++r) c[r] = cinit;
#pragma unroll
        for (int d0 = 0; d0 < 4; ++d0) { const bf16x8 kf = *(const LAS bf16x8*)(ksub + kbase + kb * 4608 + d0 * 32); c = __builtin_amdgcn_mfma_f32_32x32x16_bf16(kf, qf[d0], c, 0, 0, 0); }
        p[kb] = c;
    }
}
template <int NDB> __device__ __forceinline__ void pv(f32x16 (&o)[NDB], const LAS char* v0, const f32x16 (&p)[2], int vbase) {
#pragma unroll
    for (int kb = 0; kb < 2; ++kb)
#pragma unroll
        for (int jj = 0; jj < 2; ++jj) {
            u32x4 w; w.x = cvtpk(p[kb][8 * jj + 0], p[kb][8 * jj + 1]); w.y = cvtpk(p[kb][8 * jj + 2], p[kb][8 * jj + 3]); w.z = cvtpk(p[kb][8 * jj + 4], p[kb][8 * jj + 5]); w.w = cvtpk(p[kb][8 * jj + 6], p[kb][8 * jj + 7]);
            const bf16x8 pf = __builtin_bit_cast(bf16x8, w);
#pragma unroll
            for (int db = 0; db < NDB; ++db) {
                const LAS char* a = v0 + (db >> 1) * VSUB + vbase + kb * 4096 + jj * 1024 + (db & 1) * 512;
                const s16x4 lo = vtr(a), hi = vtr(a + 256);
                const bf16x8 vf = {lo[0], lo[1], lo[2], lo[3], hi[0], hi[1], hi[2], hi[3]};
                o[db] = __builtin_amdgcn_mfma_f32_32x32x16_bf16(vf, pf, o[db], 0, 0, 0);
            }
        }
}

__device__ __forceinline__ float fmin_s(float a, float b) { float r; asm("v_min_f32_e32 %0, %1, %2" : "=v"(r) : "v"(a), "v"(b)); return r; }
__device__ __forceinline__ float fmul_s(float a, float b) { float r; asm("v_mul_f32_e32 %0, %1, %2" : "=v"(r) : "v"(a), "v"(b)); return r; }
__device__ __forceinline__ float fsub_s(float a, float b) { float r; asm("v_sub_f32_e32 %0, %1, %2" : "=v"(r) : "v"(a), "v"(b)); return r; }
template <bool MASK> __device__ __forceinline__ void sb_weights(f32x16 (&p)[2], int lim, int hi, float& carry) {
    float T[2];
#pragma unroll
    for (int kb = 1; kb >= 0; --kb) {
        float run = 1.0f;
#pragma unroll
        for (int r = 15; r >= 0; --r) {
            float kp = __builtin_amdgcn_rcpf(1.0f + __builtin_amdgcn_exp2f(p[kb][r]));
            if (MASK) kp = (32 * kb + 16 * hi + r < lim) ? kp : 1.0f;
            const float nx = fmul_s(run, kp);
            p[kb][r] = fsub_s(run, nx);
            run = nx;
        }
        T[kb] = run;
    }
    float TA, TC; const float TB = swap_lo(T[1], TA), TD = swap_lo(T[0], TC);
    const float cA = carry * TA, cAB = cA * TB, cABC = cAB * TC;
    const float base1 = hi ? carry : cA, base0 = hi ? cAB : cABC;
    carry = cABC * TD;
#pragma unroll
    for (int r = 0; r < 16; ++r) { p[1][r] *= base1; p[0][r] *= base0; }
}
template <bool MASK> __device__ __forceinline__ void sm_weights(f32x16 (&p)[2], int lim, int hi, float& lsum) {
    float s = 0.f;
#pragma unroll
    for (int kb = 0; kb < 2; ++kb)
#pragma unroll
        for (int r = 0; r < 16; ++r) {
            float e = __builtin_amdgcn_exp2f(fmin_s(p[kb][r], 100.0f));
            if (MASK) e = (32 * kb + 16 * hi + r < lim) ? e : 0.0f;
            p[kb][r] = e; s += e;
        }
    lsum += s;
}

template <bool MASK> __device__ __forceinline__ void exp_stage(f32x16 (&p)[2], int lim, int hi) {
#pragma unroll
    for (int kb = 0; kb < 2; ++kb)
#pragma unroll
        for (int r = 0; r < 16; ++r) {
            float e = __builtin_amdgcn_exp2f(fmin_s(p[kb][r], 100.0f));
            if (MASK) e = (32 * kb + 16 * hi + r < lim) ? e : 0.0f;
            p[kb][r] = e;
        }
}
__device__ __forceinline__ void pack_stage(const f32x16 (&e)[2], bf16x8 (&pf)[4], float& lsum) {
    float s0 = 0.f, s1 = 0.f;
#pragma unroll
    for (int r = 0; r < 16; ++r) { s0 += e[0][r]; s1 += e[1][r]; }
    lsum += s0 + s1;
#pragma unroll
    for (int kb = 0; kb < 2; ++kb)
#pragma unroll
        for (int jj = 0; jj < 2; ++jj) {
            u32x4 w; w.x = cvtpk(e[kb][8 * jj + 0], e[kb][8 * jj + 1]); w.y = cvtpk(e[kb][8 * jj + 2], e[kb][8 * jj + 3]); w.z = cvtpk(e[kb][8 * jj + 4], e[kb][8 * jj + 5]); w.w = cvtpk(e[kb][8 * jj + 6], e[kb][8 * jj + 7]);
            typedef unsigned short us8_t __attribute__((ext_vector_type(8)));
            const us8_t lim8 = {0x7180, 0x7180, 0x7180, 0x7180, 0x7180, 0x7180, 0x7180, 0x7180};
            pf[kb * 2 + jj] = __builtin_bit_cast(bf16x8, __builtin_elementwise_min(__builtin_bit_cast(us8_t, w), lim8));
        }
}
template <int NDB> __device__ __forceinline__ void pv_packed(f32x16 (&o)[NDB], const LAS char* v0, const bf16x8 (&pf)[4], int vbase) {
#pragma unroll
    for (int kb = 0; kb < 2; ++kb)
#pragma unroll
        for (int jj = 0; jj < 2; ++jj)
#pragma unroll
            for (int db = 0; db < NDB; ++db) {
                const LAS char* a = v0 + (db >> 1) * VSUB + vbase + kb * 4096 + jj * 1024 + (db & 1) * 512;
                const s16x4 lo = vtr(a), hi = vtr(a + 256);
                const bf16x8 vf = {lo[0], lo[1], lo[2], lo[3], hi[0], hi[1], hi[2], hi[3]};
                o[db] = __builtin_amdgcn_mfma_f32_32x32x16_bf16(vf, pf[kb * 2 + jj], o[db], 0, 0, 0);
            }
}
template <int NDB> __device__ __forceinline__ void pipe_step(f32x16 (&o)[NDB], bf16x8 (&pf)[4], s16x4 (&vq)[8][2], float& lsum, const LAS char* kslot, const LAS char* vprev, const LAS char* vcur, const bf16x8 (&qf)[4], int kbase, int vbase) {
    static_assert(NDB == 4, "DIFF geometry");
#define DIFF_VFRAG(slot_, vs_, m_) do { const LAS char* a_ = (vs_) + (((m_) & 3) >> 1) * VSUB + vbase + ((m_) >> 3) * 4096 + (((m_) >> 2) & 1) * 1024 + ((m_) & 1) * 512; vq[slot_][0] = vtr(a_); vq[slot_][1] = vtr(a_ + 256); } while (0)
#define DIFF_PVMFMA(slot_, m_) do { const s16x4 lo_ = vq[slot_][0], hh_ = vq[slot_][1]; const bf16x8 vf_ = {lo_[0], lo_[1], lo_[2], lo_[3], hh_[0], hh_[1], hh_[2], hh_[3]}; \
        o[(m_) & 3] = __builtin_amdgcn_mfma_f32_32x32x16_bf16(vf_, pf[(m_) >> 2], o[(m_) & 3], 0, 0, 0); } while (0)
    bf16x8 kf[8];
#pragma unroll
    for (int i = 0; i < 8; ++i) kf[i] = *(const LAS bf16x8*)(kslot + kbase + (i >> 2) * 4608 + (i & 3) * 32);
    __builtin_amdgcn_sched_barrier(0);
#pragma unroll
    for (int m = 0; m < 8; ++m) { DIFF_PVMFMA(m, m); if (m < 4) DIFF_VFRAG(m, vprev, m + 8); __builtin_amdgcn_sched_barrier(0); }
    f32x16 e[2];
    {
        f32x16 c0, c1;
#pragma unroll
        for (int r = 0; r < 16; ++r) { c0[r] = 0.f; c1[r] = 0.f; }
#pragma unroll
        for (int d0 = 0; d0 < 4; ++d0) c0 = __builtin_amdgcn_mfma_f32_32x32x16_bf16(kf[d0], qf[d0], c0, 0, 0, 0);
        __builtin_amdgcn_sched_barrier(0);
#pragma unroll
        for (int d0 = 0; d0 < 4; ++d0) {
            c1 = __builtin_amdgcn_mfma_f32_32x32x16_bf16(kf[4 + d0], qf[d0], c1, 0, 0, 0);
            DIFF_VFRAG(4 + d0, vprev, 12 + d0);
#pragma unroll
            for (int r = 4 * d0; r < 4 * d0 + 4; ++r) c0[r] = __builtin_amdgcn_exp2f(c0[r]);
            __builtin_amdgcn_sched_barrier(0);
        }
        e[0] = c0; e[1] = c1;
    }
#pragma unroll
    for (int m = 8; m < 16; ++m) {
        DIFF_PVMFMA(m - 8, m); DIFF_VFRAG(m - 8, vcur, m - 8);
#pragma unroll
        for (int r = 2 * (m - 8); r < 2 * (m - 8) + 2; ++r) e[1][r] = __builtin_amdgcn_exp2f(e[1][r]);
        __builtin_amdgcn_sched_barrier(0);
    }
    pack_stage(e, pf, lsum);
    __builtin_amdgcn_sched_barrier(0);
}

template <int MODE, bool SMP = false> __device__ __forceinline__ void attn_unit(LAS char* lds, const Params& P, bool sample, int b, int hsel, int usel, const int wave_id) {
    constexpr int NKS = Geo<MODE>::NKS, NVS = Geo<MODE>::NVS, NDB = Geo<MODE>::NDB, BUFB = NKS * KSUB + NVS * VSUB;
    int tid_ = wave_id * 64 + lane_id_volatile(); asm volatile("" : "+v"(tid_));
    const int tid = tid_, lane = tid & 63, r32 = lane & 31, hi = lane >> 5;
    const int wave = wave_id;
    const int key = tid >> 3, ch = tid & 7;
    int qbw, ksub, vsub0;
    if (MODE == SB) { qbw = wave; ksub = 0; vsub0 = 0; }
    else if (MODE == DIFF) { qbw = wave & 3; ksub = wave >> 2; vsub0 = 0; }
    else { qbw = wave & 1; ksub = wave >> 1; vsub0 = wave >> 1; }
    int qrow0, nq, qpos0, qcol, kcol0, vcol0, ocol, t_lo, t_hi, npast, pastpos0, newpos0, newrow0, ppitch;
    const float* pk = nullptr; const float* pvp = nullptr;
    if (MODE == SB) {
        qcol = hsel * 64; kcol0 = 512 + hsel * 64; vcol0 = 1024 + hsel * 64; ocol = hsel * 64; ppitch = 512;
        if (!sample) { qrow0 = b * SEQ + usel * 256; nq = 256; qpos0 = usel * 256; t_lo = 0; t_hi = usel * 4 + 3; npast = 0; pastpos0 = 0; newpos0 = 0; newrow0 = b * SEQ; }
        else { qrow0 = MP + b * 32; nq = 32; qpos0 = 1024; t_lo = 0; t_hi = 16; npast = 16; pastpos0 = 0; newpos0 = 1024; newrow0 = MP + b * 32; pk = P.cK + (size_t)b * 1024 * 512 + hsel * 64; pvp = P.cV + (size_t)b * 1024 * 512 + hsel * 64; }
    } else if (MODE == DIFF) {
        qcol = 1536 + (hsel * 2 + ksub) * 64; kcol0 = 2048 + hsel * 128; vcol0 = 2560 + hsel * 128; ocol = 512 + hsel * 128; ppitch = 512;
        if (!sample) { qrow0 = b * SEQ + usel * 128; nq = 128; qpos0 = usel * 128; t_lo = 0; t_hi = usel * 2 + 1; npast = 0; pastpos0 = 0; newpos0 = 0; newrow0 = b * SEQ; }
        else { qrow0 = MP + b * 32; nq = 32; qpos0 = 1024; t_lo = 0; t_hi = 16; npast = 16; pastpos0 = 0; newpos0 = 1024; newrow0 = MP + b * 32; pk = P.cK + (size_t)b * 1024 * 512 + hsel * 128; pvp = P.cV + (size_t)b * 1024 * 512 + hsel * 128; }
    } else {
        qcol = (hsel * 4 + ksub) * 64; kcol0 = 1024 + hsel * 256; vcol0 = 2048 + hsel * 256; ocol = (hsel * 4 + ksub) * 64; ppitch = 1024;
        if (!sample) { qrow0 = b * SEQ + usel * 64; nq = 64; qpos0 = usel * 64; t_lo = usel > 8 ? usel - 8 : 0; t_hi = usel; npast = 0; pastpos0 = 0; newpos0 = 0; newrow0 = b * SEQ; }
        else { qrow0 = MP + b * 32; nq = 32; qpos0 = 1024; t_lo = 0; t_hi = 8; npast = 8; pastpos0 = 512; newpos0 = 1024; newrow0 = MP + b * 32; pk = P.cK + (size_t)b * 512 * 1024 + hsel * 256; pvp = P.cV + (size_t)b * 512 * 1024 + hsel * 256; }
    }
    const bool active = 32 * qbw < nq;
    const int nvnew = sample ? 32 : 64;
#define ATT_SRC(s_, tt_) do { const int _t = (tt_); \
        if (_t < npast) { (s_).k = pk + (size_t)_t * 64 * ppitch; (s_).v = pvp + (size_t)_t * 64 * ppitch; (s_).pitch = ppitch; (s_).f32 = 1; (s_).nvalid = 64; } \
        else { const size_t ro_ = (size_t)(newrow0 + (_t - npast) * 64) * NQKV; (s_).k = P.qkv + ro_ + kcol0; (s_).v = P.qkv + ro_ + vcol0; (s_).pitch = NQKV; (s_).f32 = 0; (s_).nvalid = nvnew; } } while (0)
    const int kbase = kpi(r32) * 144 + hi * 16;
    const int g = lane >> 4;
    const int vbase = hi * 2048 + ((lane >> 2) & 3) * 64 + (g & 1) * 32 + (lane & 3) * 8;
    const int qpos = qpos0 + 32 * qbw + r32;
    bf16x8 qf[4];
    {
        const bf16_t* qp = P.qkv + (size_t)(qrow0 + (active ? 32 * qbw : 0) + r32) * NQKV + qcol + hi * 8;
#pragma unroll
        for (int d0 = 0; d0 < 4; ++d0) qf[d0] = *(const bf16x8*)(qp + d0 * 16);
    }
    LAS float* btab = (LAS float*)(lds + ATT_BIAS_OFF);
    if (MODE == BAND) {
        for (int i = tid; i < 4 * 257; i += NTHREADS) btab[i] = P.bias[(size_t)(hsel * 4) * 257 + i] * LOG2E;
    }
    f32x16 o[NDB];
#pragma unroll
    for (int db = 0; db < NDB; ++db)
#pragma unroll
        for (int r = 0; r < 16; ++r) o[db][r] = 0.f;
    float carry = 1.0f;
    float lsum = 0.f;
#define ATT_COMPUTE() \
        const LAS char* kb_ = lds + buf * BUFB; \
 \
        const int kpos0 = (tt < npast) ? pastpos0 + 64 * tt : newpos0 + 64 * (tt - npast); \
        const int nval = (tt < npast) ? 64 : nvnew; \
        int lim; \
        if (MODE == SB) lim = qpos - kpos0; \
        else if (MODE == DIFF) lim = (qpos | 63) + 1 - kpos0; \
        else lim = 64; \
        lim = lim < nval ? lim : nval; \
        const bool any_vis = __any(lim > 0), need_mask = __any(lim < 64); \
        if (active && any_vis) { \
            f32x16 p[2]; \
            { \
                const int dbase = qpos0 + 32 * qbw - kpos0; \
                const LAS float* bt = btab + ksub * 257; \
                const bool flat = (MODE != BAND) || (dbase - 63 >= 128); \
                float cinit = 0.f; \
                if (MODE == BAND) { if (flat) cinit = bt[256]; } \
                qk(p, kb_ + ksub * KSUB, qf, kbase, cinit); \
                if (MODE == BAND) { \
                    if (!flat) { \
_Pragma("unroll") \
                        for (int kb = 0; kb < 2; ++kb) { \
                            const int d0_ = dbase + r32 - 32 * kb - 16 * hi + 128; \
_Pragma("unroll") \
                            for (int r = 0; r < 16; ++r) { int idx = d0_ - r; idx = idx < 0 ? 0 : (idx > 256 ? 256 : idx); p[kb][r] += bt[idx]; } \
                        } \
                    } \
                } \
            } \
            if (MODE == SB) { if (need_mask) sb_weights<true>(p, lim, hi, carry); else sb_weights<false>(p, lim, hi, carry); } \
            else { if (need_mask) sm_weights<true>(p, lim, hi, lsum); else sm_weights<false>(p, lim, hi, lsum); } \
            pv<NDB>(o, kb_ + NKS * KSUB + vsub0 * VSUB, p, vbase); \
        }
    int buf = 0;
    bool fast_done = false;
    if constexpr (MODE == DIFF) {
      if (!sample) {
        u32x4 kr[2][NKS], vr[2][NVS];
        const int ntile = t_hi + 1;
        const unsigned toff = (unsigned)(((newrow0 + key) * NQKV + kcol0 + ch * 8) * 2);
        static_assert((size_t)MT * NQKV * 2 < (1ull << 32), "32-bit offsets");
#define DIFF_LOAD(set_, t_) do { const int tq_ = (t_); const char* tb_ = (const char*)P.qkv + (size_t)(tq_ > 0 ? tq_ : 0) * (64 * NQKV * 2); \
            kr[set_][0] = *(const u32x4*)(tb_ + toff); kr[set_][1] = *(const u32x4*)(tb_ + toff + 128); vr[set_][0] = *(const u32x4*)(tb_ + toff + 1024); vr[set_][1] = *(const u32x4*)(tb_ + toff + 1152); } while (0)
        DIFF_LOAD(0, t_hi); tile_store<NKS, NVS>(lds, kr[0], vr[0], key, ch);
        DIFF_LOAD(1, t_hi - 1); DIFF_LOAD(0, t_hi - 2);
        __syncthreads();
        f32x16 e[2];
        { int lim = (qpos | 63) + 1 - 64 * t_hi; lim = lim < 64 ? lim : 64;
          qk(e, lds + ksub * KSUB, qf, kbase, 0.f); if (__any(lim < 64)) exp_stage<true>(e, lim, hi); else exp_stage<false>(e, lim, hi); }
        bf16x8 pf[4]; pack_stage(e, pf, lsum);
        s16x4 vq[8][2];
#pragma unroll
        for (int m = 0; m < 8; ++m) DIFF_VFRAG(m, lds + NKS * KSUB, m);
        tile_store<NKS, NVS>(lds + BUFB, kr[1], vr[1], key, ch);
        DIFF_LOAD(1, t_hi - 3);
        __syncthreads();
        int sj = 1, sp = 0;
        int j = 1;
        for (; j + 1 < ntile; j += 2) {
            pipe_step<NDB>(o, pf, vq, lsum, lds + sj * BUFB + ksub * KSUB, lds + sp * BUFB + NKS * KSUB, lds + sj * BUFB + NKS * KSUB, qf, kbase, vbase);
            int sn = (sj == 2) ? 0 : sj + 1;
            tile_store<NKS, NVS>(lds + sn * BUFB, kr[0], vr[0], key, ch);
            DIFF_LOAD(0, t_hi - j - 3);
            __syncthreads();
            sp = sj; sj = sn;
            pipe_step<NDB>(o, pf, vq, lsum, lds + sj * BUFB + ksub * KSUB, lds + sp * BUFB + NKS * KSUB, lds + sj * BUFB + NKS * KSUB, qf, kbase, vbase);
            sn = (sj == 2) ? 0 : sj + 1;
            tile_store<NKS, NVS>(lds + sn * BUFB, kr[1], vr[1], key, ch);
            DIFF_LOAD(1, t_hi - j - 4);
            __syncthreads();
            sp = sj; sj = sn;
        }
        if (j < ntile) {
            pipe_step<NDB>(o, pf, vq, lsum, lds + sj * BUFB + ksub * KSUB, lds + sp * BUFB + NKS * KSUB, lds + sj * BUFB + NKS * KSUB, qf, kbase, vbase);
            __syncthreads();
            sp = sj;
        }
        pv_packed<NDB>(o, lds + sp * BUFB + NKS * KSUB, pf, vbase);
        __syncthreads();
#undef DIFF_LOAD
#undef DIFF_VFRAG
#undef DIFF_PVMFMA
        fast_done = true;
      }
    }
    if (!fast_done) {
        LAS int* dflag = (LAS int*)(lds + ATT_BIAS_OFF);
        u32x4 kr[NKS], vr[NVS];
        { TileSrc s0; ATT_SRC(s0, t_hi); tile_load<NKS, NVS>(kr, vr, s0, key, ch); tile_store<NKS, NVS>(lds, kr, vr, key, ch); }
        __syncthreads();
        bool stop = false;
        for (int tt = t_hi; tt >= t_lo && !stop; --tt) {
            const bool more = tt > t_lo;
            f32x4 ta[SMP ? NKS : 1][2], tb[SMP ? NVS : 1][2]; bool raw32 = false;
            if (more) { TileSrc s1; ATT_SRC(s1, tt - 1);
                if constexpr (SMP) { raw32 = s1.f32 != 0;
                    if (raw32) { const float* kp = (const float*)s1.k + (size_t)key * s1.pitch + ch * 8; const float* vp = (const float*)s1.v + (size_t)key * s1.pitch + ch * 8;
#pragma unroll
                        for (int i = 0; i < NKS; ++i) { ta[i][0] = *(const f32x4*)(kp + i * 64); ta[i][1] = *(const f32x4*)(kp + i * 64 + 4); }
#pragma unroll
                        for (int i = 0; i < NVS; ++i) { tb[i][0] = *(const f32x4*)(vp + i * 64); tb[i][1] = *(const f32x4*)(vp + i * 64 + 4); } }
                    else tile_load<NKS, NVS>(kr, vr, s1, key, ch);
                } else tile_load<NKS, NVS>(kr, vr, s1, key, ch); }
            ATT_COMPUTE()
            if (MODE == SB) { const bool wdead = !active || __all(carry < 1e-30f); if (lane == 0) dflag[buf * 8 + wave] = wdead ? 1 : 0; }
            if constexpr (SMP) { if (more && raw32) {
#pragma unroll
                for (int i = 0; i < NKS; ++i) kr[i] = pack8(ta[i][0], ta[i][1]);
#pragma unroll
                for (int i = 0; i < NVS; ++i) vr[i] = pack8(tb[i][0], tb[i][1]); } }
            if (more) tile_store<NKS, NVS>(lds + (buf ^ 1) * BUFB, kr, vr, key, ch);
            __syncthreads();
            if (MODE == SB) { int a = 1;
#pragma unroll
                for (int w = 0; w < 8; ++w) a &= dflag[buf * 8 + w];
                stop = a != 0; }
            buf ^= 1;
        }
    }
#undef ATT_COMPUTE
    int r32e = lane_id_volatile() & 31;
    bf16_t* orow = P.o + (size_t)(qrow0 + 32 * qbw + r32e) * D + ocol;
    if (MODE == SB) {
        if (active) {
#pragma unroll
            for (int db = 0; db < NDB; ++db)
#pragma unroll
                for (int rg = 0; rg < 4; ++rg) { u32x2 w; w.x = cvtpk(o[db][4 * rg], o[db][4 * rg + 1]); w.y = cvtpk(o[db][4 * rg + 2], o[db][4 * rg + 3]); st8(orow + 32 * db + 8 * rg + 4 * hi, w, sample); }
        }
    } else if (MODE == BAND) {
        float lh; const float ll = swap_lo(lsum, lh); const float inv = 1.0f / (ll + lh);
        if (active) {
#pragma unroll
            for (int db = 0; db < NDB; ++db)
#pragma unroll
                for (int rg = 0; rg < 4; ++rg) { u32x2 w; w.x = cvtpk(o[db][4 * rg] * inv, o[db][4 * rg + 1] * inv); w.y = cvtpk(o[db][4 * rg + 2] * inv, o[db][4 * rg + 3] * inv); st8(orow + 32 * db + 8 * rg + 4 * hi, w, sample); }
        }
    } else {
        float lh; const float ll = swap_lo(lsum, lh); const float inv = 1.0f / (ll + lh);
        LAS float* xch = (LAS float*)lds + (size_t)qbw * 128 * 32;
        if (active && ksub == 1) {
            const float* lp_ = P.lamp; asm volatile("" : "+s"(lp_));
            const float f = lp_[0] * inv;
#pragma unroll
            for (int db = 0; db < NDB; ++db)
#pragma unroll
                for (int r = 0; r < 16; ++r) xch[(32 * db + 8 * (r >> 2) + 4 * hi + (r & 3)) * 32 + r32] = o[db][r] * f;
        }
        __syncthreads();
        if (active && ksub == 0) {
            float ssq = 0.f;
#pragma unroll
            for (int db = 0; db < NDB; ++db)
#pragma unroll
                for (int r = 0; r < 16; ++r) { const float a = o[db][r] * inv - xch[(32 * db + 8 * (r >> 2) + 4 * hi + (r & 3)) * 32 + r32]; o[db][r] = a; ssq += a * a; }
            float sh; const float sl = swap_lo(ssq, sh);
            const float* lp_ = P.lamp; asm volatile("" : "+s"(lp_));
            const float rn = rsqrtf((sl + sh) * (1.0f / 128.0f) + EPS) * (1.0f - lp_[1]);
            const float* gp = P.gain + hsel * 128;
#pragma unroll
            for (int db = 0; db < NDB; ++db)
#pragma unroll
                for (int rg = 0; rg < 4; ++rg) {
                    const int d = 32 * db + 8 * rg + 4 * hi;
                    const f32x4 gv = *(const f32x4*)(gp + d);
                    u32x2 w; w.x = cvtpk(o[db][4 * rg] * rn * gv[0], o[db][4 * rg + 1] * rn * gv[1]); w.y = cvtpk(o[db][4 * rg + 2] * rn * gv[2], o[db][4 * rg + 3] * rn * gv[3]);
                    st8(orow + d, w, sample);
                }
        }
    }
    __syncthreads();
#undef ATT_SRC
}
}
typedef GAS unsigned gu32;
#define XB_TMO      128
#define XB_XCNT(j)  (256  + 64 * (j))
#define XB_XSUB(j)  (1280 + 64 * (j))
#define XB_XGEN(j)  (2304 + 64 * (j))
#define XB_TOP      3328
#define XB_TOPGEN   3392
#define XCD_BAR_WORDS 3456
#define XB_SPIN_CAP (1u << 18)

__device__ __forceinline__ unsigned xb_ld(unsigned* p)              { return __hip_atomic_load(p, __ATOMIC_RELAXED, __HIP_MEMORY_SCOPE_AGENT); }
__device__ __forceinline__ unsigned xb_add(unsigned* p, unsigned v) { return __hip_atomic_fetch_add(p, v, __ATOMIC_RELAXED, __HIP_MEMORY_SCOPE_AGENT); }
__device__ __forceinline__ unsigned xb_xcc_id() { return (unsigned)__builtin_amdgcn_s_getreg((3 << 11) | 20) & 0xFu; }
#define XB_SPIN(cond, bar) do { unsigned _sp = 0; while (cond) { __builtin_amdgcn_s_sleep(1); \
    if ((++_sp & 255u) == 0u) { if (xb_ld(&(bar)[XB_TMO])) break; if (_sp > XB_SPIN_CAP) { atomicAdd(&(bar)[XB_TMO], 1u); break; } } } } while (0)

struct XcdBarrier {
    unsigned* bar; unsigned x;
    volatile LAS unsigned* st;
};

__device__ __forceinline__ XcdBarrier xcd_barrier_post(unsigned* bar, volatile LAS unsigned* st) {
    XcdBarrier b; b.bar = bar; b.x = xb_xcc_id(); b.st = st;
    if (threadIdx.x == 0) (void)xb_add(&bar[XB_XCNT(b.x)], 1u);
    return b;
}
__device__ __forceinline__ void xcd_barrier_complete(unsigned* bar, unsigned x, unsigned& nloc, unsigned& nx) {
    const unsigned G = gridDim.x * gridDim.y * gridDim.z;
    unsigned sum, cnt, mine, sp = 0u;
    for (;;) {
        sum = 0u; cnt = 0u; mine = 0u;
#pragma unroll
        for (unsigned j = 0; j < 16; ++j) { const unsigned c = xb_ld(&bar[XB_XCNT(j)]); sum += c; cnt += (c > 0u) ? 1u : 0u; mine = (j == x) ? c : mine; }
        if (sum == G) break;
        __builtin_amdgcn_s_sleep(1);
        if ((++sp & 255u) == 0u) { if (xb_ld(&bar[XB_TMO])) break; if (sp > XB_SPIN_CAP) { atomicAdd(&bar[XB_TMO], 1u); break; } }
    }
    nloc = mine > 0u ? mine : 1u; nx = cnt > 0u ? cnt : 1u;
}

__device__ __forceinline__ void xcd_barrier(const XcdBarrier& b) {
    asm volatile("s_waitcnt vmcnt(0)" ::: "memory");
    __syncthreads();
    if (threadIdx.x == 0) {
        unsigned* bar = b.bar;
        __builtin_amdgcn_s_waitcnt(0);
        unsigned nloc = b.st[0], nx = b.st[1];
        if (nloc == 0u) { xcd_barrier_complete(bar, b.x, nloc, nx); b.st[0] = nloc; b.st[1] = nx; }
        const unsigned old = xb_add(&bar[XB_XSUB(b.x)], 1u);
        const unsigned gen = old / nloc;
        if (old + 1u == (gen + 1u) * nloc) {
            __builtin_amdgcn_fence(__ATOMIC_RELEASE, "agent");
            asm volatile("s_waitcnt vmcnt(0)" ::: "memory");
            const unsigned og = xb_add(&bar[XB_TOP], 1u);
            const unsigned tg = og / nx;
            if (og + 1u == (tg + 1u) * nx) xb_add(&bar[XB_TOPGEN], 1u);
            else XB_SPIN(xb_ld(&bar[XB_TOPGEN]) == tg, bar);
            __builtin_amdgcn_fence(__ATOMIC_ACQUIRE, "agent");
            xb_add(&bar[XB_XGEN(b.x)], 1u);
            asm volatile("s_waitcnt vmcnt(0)" ::: "memory");
        } else {
            XB_SPIN(xb_ld(&bar[XB_XGEN(b.x)]) == gen, bar);
            __builtin_amdgcn_fence(__ATOMIC_ACQUIRE, "agent");
            asm volatile("s_waitcnt vmcnt(0)" ::: "memory");
        }
    }
    __syncthreads();
}

#ifndef CHAIN
#define CHAIN 1
#endif
#ifndef SAMPLE_SMALL
#define SAMPLE_SMALL 0
#endif
#ifndef QKV_REP
#define QKV_REP 1
#endif
#ifndef GU_REP
#define GU_REP 1
#endif
#ifndef ATT_REP_EVEN
#define ATT_REP_EVEN 1
#endif
#ifndef ATT_REP_ODD
#define ATT_REP_ODD 1
#endif
#ifndef EN_P0
#define EN_P0 1
#endif
#ifndef EN_QKV
#define EN_QKV 1
#endif
#ifndef EN_ATT
#define EN_ATT 1
#endif
#ifndef EN_OUT
#define EN_OUT 1
#endif
#ifndef EN_GU
#define EN_GU 1
#endif
#ifndef EN_DN
#define EN_DN 1
#endif
#ifndef EN_PLE
#define EN_PLE 1
#endif
__device__ __forceinline__ int dest_row(int map, int c) {
    if (map == 1) { if (c >= 1536 && c < 2560) { const int l = c & 63, half = l >> 5, i = l & 31; return (c & ~63) + 32 * (i >> 4) + 8 * ((i >> 2) & 3) + 4 * half + (i & 3); } return c; }
    if (map == 2) return 8 * (c >> 2) + (c & 3);
    if (map == 3) return 8 * (c >> 2) + 4 + (c & 3);
    return c;
}
__device__ __forceinline__ void transpose_item(const float* W, int K, int N, bf16_t* WT, const float* gain, int map, LAS float* scr, int item, int lane) {
    const int nblk = N / 32, kb = item / nblk, nb = item % nblk, k0 = 64 * kb, n0 = 32 * nb;
    float wv[32];
#pragma unroll
    for (int i = 0; i < 32; ++i) wv[i] = W[(size_t)(k0 + 2 * i + (lane >> 5)) * N + n0 + (lane & 31)];
#pragma unroll
    for (int i = 0; i < 32; ++i) { const int kk = 2 * i + (lane >> 5); const float gk = gain ? gain[k0 + kk] : 1.0f; scr[kk * 33 + (lane & 31)] = wv[i] * gk; }
    LDS_WAIT(); asm volatile("" ::: "memory");
    const int c = lane & 7;
#pragma unroll
    for (int j = 0; j < 4; ++j) { const int n = (lane >> 3) + 8 * j; const LAS float* s = scr + (8 * c) * 33 + n;
        u32x4 o; o.x = cvtpk(s[0 * 33], s[1 * 33]); o.y = cvtpk(s[2 * 33], s[3 * 33]); o.z = cvtpk(s[4 * 33], s[5 * 33]); o.w = cvtpk(s[6 * 33], s[7 * 33]);
        *(u32x4*)(WT + (size_t)dest_row(map, n0 + n) * K + k0 + 8 * c) = o; }
    LDS_WAIT(); asm volatile("" ::: "memory");
}

__device__ __forceinline__ unsigned chain_kind(unsigned st) { const unsigned r = st % 12u; return (r == 0u || r == 6u) ? 0u : (r < 6u ? r : r - 6u); }
__device__ __forceinline__ unsigned chain_layer(unsigned st) { const unsigned r = st % 12u; return 2u * (st / 12u) + (r >= 6u ? 1u : 0u); }
__device__ __forceinline__ unsigned chain_n(unsigned st) { const unsigned k = chain_kind(st); return k == 0u ? 48u : k == 1u ? ((st % 12u) == 1u ? 384u : 128u) : k == 3u ? 88u : k == 4u ? 32u : 16u; }
constexpr int MROWS = (SAMPLE_SMALL || CHAIN) ? MP : MT;
struct Args { const float* in[26]; float* out; unsigned char* ws; };

__global__ void __launch_bounds__(NTHREADS, 2) trunk_fwd(Args args) {
    extern __shared__ __attribute__((aligned(16))) unsigned char lds_raw[];
    LAS unsigned char* lds = (LAS unsigned char*)lds_raw;
    volatile LAS unsigned* MISC = (volatile LAS unsigned*)(lds + LDSCTL_OFF);
    const int wave = __builtin_amdgcn_readfirstlane((int)threadIdx.x >> 6);
#define LANE_TID() const int lane = lane_id_volatile(); const int tid = wave * 64 + lane; (void)tid; (void)lane
    const int G = gridDim.x;
    typedef __attribute__((address_space(4))) const Args CArgs;
#define ARGS_HERE() CArgs* ap = (CArgs*)__builtin_amdgcn_kernarg_segment_ptr(); asm volatile("" : "+s"(ap)); unsigned char* ws = ap->ws; (void)ws
#define WSPTRS() ss_t* ssb = (ss_t*)(ws + WS_SS); float* hf = (float*)(ws + WS_H); bf16_t* hb = (bf16_t*)(ws + WS_HB); bf16_t* hb2 = (bf16_t*)(ws + WS_HB2); (void)hb2; bf16_t* qkv = (bf16_t*)(ws + WS_QKV); bf16_t* act = (bf16_t*)(ws + WS_ACT); \
    bf16_t* ob = (bf16_t*)(ws + WS_O); bf16_t* plb = (bf16_t*)(ws + WS_PL); bf16_t* pb = (bf16_t*)(ws + WS_PB); float* ropec = (float*)(ws + WS_ROPEC); float* ropes = (float*)(ws + WS_ROPES); float* lamv = (float*)(ws + WS_LAM); \
    (void)ssb; (void)hf; (void)hb; (void)qkv; (void)act; (void)ob; (void)plb; (void)pb; (void)ropec; (void)ropes; (void)lamv
    { LANE_TID(); for (int u = tid; u < (LDS_BYTES - LDSCTL_OFF) / 4; u += NTHREADS) MISC[u] = 0u; }
    __syncthreads();
    { LANE_TID(); if (tid == 0) (void)xb_add(&((unsigned*)(args.ws + WS_CTL) + CW_BAR)[XB_XCNT(xb_xcc_id())], 1u); }
#define GRID_BARRIER() do { CArgs* ap_ = (CArgs*)__builtin_amdgcn_kernarg_segment_ptr(); asm volatile("" : "+s"(ap_)); XcdBarrier b_; b_.bar = (unsigned*)(ap_->ws + WS_CTL) + CW_BAR; b_.x = xb_xcc_id(); b_.st = MISC + 8; xcd_barrier(b_); } while (0)

#if EN_P0
    {
        ARGS_HERE(); WSPTRS(); LANE_TID();
        const float* x_prompt = ap->in[0]; const float* x_sample = ap->in[1]; const float* p_prompt = ap->in[8]; const float* p_sample = ap->in[9];
        const float* norm_mix = ap->in[10]; const float* w_in_even = ap->in[11]; const float* w_out_even = ap->in[12]; const float* diff_lambda = ap->in[13];
        const float* w_in_odd = ap->in[15]; const float* w_out_odd = ap->in[16]; const float* norm_ffn = ap->in[18];
        const float* w_gate = ap->in[19]; const float* w_up = ap->in[20]; const float* w_down = ap->in[21]; const float* norm_ple = ap->in[22]; const float* w_ple_gate = ap->in[23]; const float* w_ple = ap->in[24];
        const int gw = blockIdx.x * NWAVES + wave, NGW = G * NWAVES;
        LAS float* scr = (LAS float*)(lds + wave * 16384);
        constexpr int I_IN = 16 * 96, I_OUT = 16 * 32, I_G = 16 * 88, I_DN = 44 * 32, I_PG = 16 * 32, I_PL = 4 * 32, I_LAYER = I_IN + I_OUT + 2 * I_G + I_DN + I_PG + I_PL;
        for (int it = gw; it < NLAYER * I_LAYER; it += NGW) {
            const int li = it / I_LAYER; int r = it % I_LAYER; const int eo = li >> 1;
            unsigned char* wl = ws + WS_W + (size_t)li * W_LAYER;
            if (r < I_IN) { const float* W = (li & 1) ? w_in_odd + (size_t)eo * D * NQKV : w_in_even + (size_t)eo * D * NQKV; transpose_item(W, D, NQKV, (bf16_t*)(wl + WO_IN), norm_mix + li * D, (li & 1) ? 0 : 1, scr, r, lane); continue; } r -= I_IN;
            if (r < I_OUT) { const float* W = (li & 1) ? w_out_odd + (size_t)eo * D * D : w_out_even + (size_t)eo * D * D; transpose_item(W, D, D, (bf16_t*)(wl + WO_OUT), nullptr, 0, scr, r, lane); continue; } r -= I_OUT;
            if (r < I_G) { transpose_item(w_gate + (size_t)li * D * FFN, D, FFN, (bf16_t*)(wl + WO_GU), norm_ffn + li * D, 2, scr, r, lane); continue; } r -= I_G;
            if (r < I_G) { transpose_item(w_up + (size_t)li * D * FFN, D, FFN, (bf16_t*)(wl + WO_GU), norm_ffn + li * D, 3, scr, r, lane); continue; } r -= I_G;
            if (r < I_DN) { transpose_item(w_down + (size_t)li * FFN * D, FFN, D, (bf16_t*)(wl + WO_DN), nullptr, 0, scr, r, lane); continue; } r -= I_DN;
            if (r < I_PG) { transpose_item(w_ple_gate + (size_t)li * D * D, D, D, (bf16_t*)(wl + WO_PG), norm_ple + li * D, 0, scr, r, lane); continue; } r -= I_PG;
            transpose_item(w_ple + (size_t)li * PLE * D, PLE, D, (bf16_t*)(wl + WO_PL), nullptr, 0, scr, r, lane);
        }
        for (int r0 = gw; r0 < MT; r0 += 2 * NGW) {
            f32x4 v[2][4];
#pragma unroll
            for (int q = 0; q < 2; ++q) { const int r = r0 + q * NGW; if (r < MT) { const float* xr = (r < MP) ? x_prompt + (size_t)r * D : x_sample + (size_t)(r - MP) * D;
#pragma unroll
                for (int j = 0; j < 4; ++j) v[q][j] = *(const f32x4*)(xr + 4 * lane + 256 * j); } }
#pragma unroll
            for (int q = 0; q < 2; ++q) { const int r = r0 + q * NGW; if (r < MT) { float s = 0.f;
#pragma unroll
                for (int j = 0; j < 4; ++j) { const f32x4 x4 = v[q][j]; s += (x4[0] * x4[0] + x4[1] * x4[1]) + (x4[2] * x4[2] + x4[3] * x4[3]);
                    u32x2 w; w.x = cvtpk(x4[0], x4[1]); w.y = cvtpk(x4[2], x4[3]); *(u32x2*)(hb2 + (size_t)r * D + 4 * lane + 256 * j) = w; }
                s = wave_sum(s);
                if (lane == 0) ssb[r] = (ss_t)__float2ull_rn(s * SS_SCALE); } }
        }
        for (int it0 = gw; it0 < NLAYER * MT; it0 += 8 * NGW) {
            f32x4 v[8];
#pragma unroll
            for (int q = 0; q < 8; ++q) { const int it = it0 + q * NGW; if (it < NLAYER * MT) { const int li = it / MT, r = it % MT;
                const float* pr = (r < MP) ? p_prompt + ((size_t)li * MP + r) * PLE : p_sample + ((size_t)li * MS + (r - MP)) * PLE; v[q] = *(const f32x4*)(pr + 4 * lane); } }
#pragma unroll
            for (int q = 0; q < 8; ++q) { const int it = it0 + q * NGW; if (it < NLAYER * MT) { u32x2 w; w.x = cvtpk(v[q][0], v[q][1]); w.y = cvtpk(v[q][2], v[q][3]); *(u32x2*)(pb + (size_t)it * PLE + 4 * lane) = w; } }
        }
        for (int idx = blockIdx.x * NTHREADS + tid; idx < SEQ * 32; idx += G * NTHREADS) {
            const int pos = idx >> 5, i = idx & 31;
            const float inv = exp2f(-(float)i * (13.287712379549449f / 32.0f));
            const float ang = (float)pos * inv;
            const double rev = (double)ang * 0.15915494309189535;
            const double fr = rev - rint(rev);
            const float a = (float)(fr * 6.283185307179586);
            ropec[idx] = cosf(a); ropes[idx] = sinf(a);
        }
        if (blockIdx.x == 0 && wave < 2) {
            const float* lp = diff_lambda + wave * 256;
            const float s1 = wave_sum(lp[lane] * lp[64 + lane]), s2 = wave_sum(lp[128 + lane] * lp[192 + lane]);
            const float li_ = 0.8f - 0.6f * expf(-0.3f * (float)(2 * wave));
            if (lane == 0) { lamv[2 * wave] = expf(s1) - expf(s2) + li_; lamv[2 * wave + 1] = li_; }
        }
    }
#endif
    GRID_BARRIER();

    for (int li = 0; li < NLAYER; ++li) {
        const int eo = li >> 1;
#define LAYER_PTRS() ARGS_HERE(); WSPTRS(); unsigned char* wl = ws + WS_W + (size_t)li * W_LAYER; float* out = ap->out; (void)out; (void)wl; \
        const ss_t* ss_mix = ssb + (size_t)(3 * li) * MT; ss_t* ss_ffn = ssb + (size_t)(3 * li + 1) * MT; ss_t* ss_ple = ssb + (size_t)(3 * li + 2) * MT; ss_t* ss_nxt = ssb + (size_t)(3 * li + 3) * MT; \
        (void)ss_mix; (void)ss_ffn; (void)ss_ple; (void)ss_nxt
#if EN_QKV
        for (int rep_ = 0; rep_ < QKV_REP; ++rep_) {
            if (rep_) GRID_BARRIER();
            LAYER_PTRS();
            const bf16_t* Bw = (const bf16_t*)(wl + WO_IN);
            pg8::Gemm g{hb2, Bw, MROWS, NQKV, D}; pg8::StaticOrder S; S.init(MROWS, NQKV, G, (int)blockIdx.x);
            if (li & 1) { BigEpi<RQkvOdd> E{{qkv, ss_mix, out, eo, nullptr, false}}; if (SAMPLE_SMALL) small_gemm(hb2, Bw, NQKV, D, E.e, wave, G); pg8::gemm_phase<BigEpi<RQkvOdd>, pg8::StaticOrder, true, true>(lds, g, S, E, wave); }
            else { BigEpi<RQkvEven> E{{qkv, ss_mix, ropec, ropes, out, eo, nullptr, false}}; if (SAMPLE_SMALL) small_gemm(hb2, Bw, NQKV, D, E.e, wave, G); pg8::gemm_phase<BigEpi<RQkvEven>, pg8::StaticOrder, true, true>(lds, g, S, E, wave); }
        }
#endif
        GRID_BARRIER();
#if EN_ATT
        {
            LAYER_PTRS();
            const float* cache_sb_k = ap->in[2]; const float* cache_sb_v = ap->in[3]; const float* cache_diff_k = ap->in[4]; const float* cache_diff_v = ap->in[5];
            const float* cache_band_k = ap->in[6]; const float* cache_band_v = ap->in[7]; const float* diff_norm = ap->in[14]; const float* rel_bias = ap->in[17]; const float* x_sample = ap->in[1];
            LANE_TID();
            for (int rep = 0; rep < ((li & 1) ? ATT_REP_ODD : ATT_REP_EVEN); ++rep) {
            if (rep) GRID_BARRIER();
            const bool even = !(li & 1);
            const unsigned NUQ = 256u;
            const unsigned NST = (rep == 0 && CHAIN) ? 24u : 0u;
            const unsigned SEND = NST ? 12u * (unsigned)(li >> 1) + ((li & 1) ? 12u : 7u) : 0u;
            unsigned* ctlw = (unsigned*)(ws + WS_CTL);
            unsigned* qbase = ctlw + CW_QUEUE + 64 * 8 * (li + 4 * rep);
            unsigned* chain = ctlw + CW_CHAIN;
#define CHAIN_N(st_) chain_n(st_)
            if (tid == 0) { MISC[19] = xb_xcc_id() & 7u; MISC[22] = 0u; MISC[23] = 0u; }
            __syncthreads();
            int npoll = 0;
            for (;;) {
                if (tid == 0) {
                    unsigned got = 0u, st = NST;
                    if (NST) {
                        st = atomicAdd(chain, 0u);
                        if (st < SEND) { const unsigned n = CHAIN_N(st);
                            if (MISC[23] != st + 1u) { const unsigned i = atomicAdd(chain + 64 * (1 + st), 1u);
                                if (i < n) { got = 1u; MISC[17] = st; MISC[18] = i; __builtin_amdgcn_fence(__ATOMIC_ACQUIRE, "agent"); } else MISC[23] = st + 1u; } }
                    }
                    unsigned ui = 0xffffffffu;
                    if (!got) { unsigned xq = MISC[19], tr = MISC[22];
                        while (tr < 8u) { const unsigned i = atomicAdd(qbase + 64 * xq, 1u); if (i < NUQ) { ui = i; break; } xq = (xq + 1u) & 7u; ++tr; }
                        MISC[19] = xq; MISC[22] = tr; }
                    MISC[16] = ui; MISC[20] = got; MISC[21] = st;
                    asm volatile("s_waitcnt vmcnt(0)" ::: "memory");
                }
                __syncthreads();
                const unsigned ui = __builtin_amdgcn_readfirstlane(MISC[16]), got = __builtin_amdgcn_readfirstlane(MISC[20]), stv = __builtin_amdgcn_readfirstlane(MISC[21]);
                const unsigned cst = __builtin_amdgcn_readfirstlane(MISC[17]), ci = __builtin_amdgcn_readfirstlane(MISC[18]), xq = __builtin_amdgcn_readfirstlane(MISC[19]);
                __syncthreads();
                int mode = -1, b = 0, hsel = 0, usel = 0, gkind = 0, gL = li, gitem = 0; bool sample = false;
                if (got) {
                    const unsigned s6 = chain_kind(cst); gL = (int)chain_layer(cst); sample = true;
                    if (s6 == 0u) { gkind = (gL & 1) ? 1 : 0; gitem = (int)ci; }
                    else if (s6 == 1u) { if (gL & 1) { mode = 2; b = (int)(ci >> 2); hsel = (int)(ci & 3u); }
                                         else if (ci < 256u) { mode = 0; b = (int)(ci >> 3); hsel = (int)(ci & 7u); }
                                         else { const unsigned j = ci - 256u; mode = 1; b = (int)(j >> 2); hsel = (int)(j & 3u); } }
                    else if (s6 == 2u) { gkind = 2; gitem = (int)ci; }
                    else if (s6 == 3u) { gkind = 3; gitem = (int)ci; }
                    else if (s6 == 4u) { if (ci < 16u) { gkind = 4; gitem = (int)ci; } else { gkind = 5; gitem = (int)ci - 16; } }
                    else { gkind = 6; gitem = (int)ci; }
                } else if (ui != 0xffffffffu) {
                    if (even) { if (ui < 128u) { const int p = (int)(xq + 8u * (ui >> 6)); mode = 1; b = p >> 2; hsel = p & 3; usel = 63 - (int)(ui & 63u); }
                                else { const unsigned j = ui - 128u; const int q = (int)(xq + 8u * (j >> 5)); mode = 0; b = q >> 3; hsel = q & 7; usel = 31 - (int)(j & 31u); } }
                    else { const int p = (int)(xq + 8u * (ui >> 7)); mode = 2; b = p >> 2; hsel = p & 3; usel = 127 - (int)(ui & 127u); }
                } else {
                    if (stv >= SEND) break;
                    __builtin_amdgcn_s_sleep(64); if (blockIdx.x & 3) { __builtin_amdgcn_s_sleep(64); __builtin_amdgcn_s_sleep(64); }
                    if (++npoll > (1 << 20)) break; continue;
                }
                const size_t eoL = (size_t)(gL >> 1);
                if (mode == 0) { const att::Params PS{qkv, ob, cache_sb_k + eoL * 32 * 1024 * 512, cache_sb_v + eoL * 32 * 1024 * 512, nullptr, nullptr, nullptr};
                    if (sample) att::attn_unit<att::SB, true>((LAS char*)lds, PS, sample, b, hsel, usel, wave); else att::attn_unit<att::SB>((LAS char*)lds, PS, sample, b, hsel, usel, wave); }
                else if (mode == 1) { const att::Params PD{qkv, ob, cache_diff_k + eoL * 32 * 1024 * 512, cache_diff_v + eoL * 32 * 1024 * 512, diff_norm + eoL * 512, nullptr, lamv + 2 * eoL};
                    if (sample) att::attn_unit<att::DIFF, true>((LAS char*)lds, PD, sample, b, hsel, usel, wave); else att::attn_unit<att::DIFF>((LAS char*)lds, PD, sample, b, hsel, usel, wave); }
                else if (mode == 2) { const att::Params PB{qkv, ob, cache_band_k + eoL * 32 * 512 * 1024, cache_band_v + eoL * 32 * 512 * 1024, nullptr, rel_bias + eoL * 16 * 257, nullptr};
                    if (sample) att::attn_unit<att::BAND, true>((LAS char*)lds, PB, sample, b, hsel, usel, wave); else att::attn_unit<att::BAND>((LAS char*)lds, PB, sample, b, hsel, usel, wave); }
                else {
                    unsigned char* wl2 = ws + WS_W + (size_t)gL * W_LAYER;
                    const bf16_t* A; const bf16_t* Bw; int N_, K_; ss_t* ssn2 = nullptr;
                    if (gkind <= 1) { A = hb2; Bw = (const bf16_t*)(wl2 + WO_IN); N_ = NQKV; K_ = D; }
                    else if (gkind == 2) { A = ob; Bw = (const bf16_t*)(wl2 + WO_OUT); N_ = D; K_ = D; ssn2 = ssb + (size_t)(3 * gL + 1) * MT; }
                    else if (gkind == 3) { A = hb; Bw = (const bf16_t*)(wl2 + WO_GU); N_ = NGU; K_ = D; }
                    else if (gkind == 4) { A = act; Bw = (const bf16_t*)(wl2 + WO_DN); N_ = D; K_ = FFN; ssn2 = ssb + (size_t)(3 * gL + 2) * MT; }
                    else if (gkind == 5) { A = pb + (size_t)gL * MT * PLE; Bw = (const bf16_t*)(wl2 + WO_PL); N_ = D; K_ = PLE; }
                    else { A = hb; Bw = (const bf16_t*)(wl2 + WO_PG); N_ = D; K_ = D; ssn2 = ssb + (size_t)(3 * gL + 3) * MT; }
                    const pg8::Gemm g{A, Bw, MT, N_, K_}; const pg8::OneUnit S1{{128 + (gitem & 3), gitem >> 2}};
                    const AnyEpi E{gkind, gL, ws, out, x_sample, ssn2};
                    pg8::gemm_phase<AnyEpi, pg8::OneUnit, true, false>(lds, g, S1, E, wave);
                }
                if (got) {
                    asm volatile("s_waitcnt vmcnt(0)" ::: "memory");
                    __syncthreads();
                    if (tid == 0) {
                        const unsigned d = atomicAdd(chain + 64 * (32 + cst), 1u);
                        if (d + 1u == CHAIN_N(cst)) (void)atomicAdd(chain, 1u);
                    }
                }
            }
#undef CHAIN_N
            }
        }
#endif
        GRID_BARRIER();
#if EN_OUT
        {
            LAYER_PTRS(); const float* x_prompt = ap->in[0]; const float* x_sample = ap->in[1];
            const bf16_t* Bw = (const bf16_t*)(wl + WO_OUT);
            pg8::Gemm g{ob, Bw, MROWS, D, D}; pg8::StaticOrder S; S.init(MROWS, D, G, (int)blockIdx.x);
            BigEpi<RResid> E{{li == 0 ? x_prompt : hf, li == 0 ? x_sample : hf + (size_t)MP * D, hb2, H_BF16 ? nullptr : hf, hb, ss_ffn, false}};
            if (SAMPLE_SMALL) small_gemm(ob, Bw, D, D, E.e, wave, G);
            pg8::gemm_phase<BigEpi<RResid>, pg8::StaticOrder, true, true>(lds, g, S, E, wave);
        }
#endif
        GRID_BARRIER();
#if EN_GU
        for (int rep_ = 0; rep_ < GU_REP; ++rep_) {
            if (rep_) GRID_BARRIER();
            LAYER_PTRS();
            const bf16_t* Bw = (const bf16_t*)(wl + WO_GU);
            pg8::Gemm g{hb, Bw, MROWS, NGU, D}; pg8::StaticOrder S; S.init(MROWS, NGU, G, (int)blockIdx.x);
            BigEpi<RGateUp> E{{act, ss_ffn, nullptr, false}};
            if (SAMPLE_SMALL) small_gemm(hb, Bw, NGU, D, E.e, wave, G);
            pg8::gemm_phase<BigEpi<RGateUp>, pg8::StaticOrder, true, true>(lds, g, S, E, wave);
        }
#endif
        GRID_BARRIER();
#if EN_DN
        {
            LAYER_PTRS();
            const bf16_t* Bw = (const bf16_t*)(wl + WO_DN);
            pg8::Gemm g{act, Bw, MROWS, D, FFN}; pg8::StaticOrder S; S.init(MROWS, D, G, (int)blockIdx.x);
            BigEpi<RResid> E{{hf, hf + (size_t)MP * D, H_BF16 ? hb : nullptr, H_BF16 ? nullptr : hf, hb, ss_ple, false}};
            if (SAMPLE_SMALL) small_gemm(act, Bw, D, FFN, E.e, wave, G);
            pg8::gemm_phase<BigEpi<RResid>, pg8::StaticOrder, true, true>(lds, g, S, E, wave);
            { const bf16_t* Apl = pb + (size_t)li * MT * PLE; const bf16_t* Bw2 = (const bf16_t*)(wl + WO_PL); pg8::Gemm g2{Apl, Bw2, MROWS, D, PLE}; BigEpi<RPl> E2{{plb, nullptr, false}};
              __syncthreads();
              pg8::gemm_phase<BigEpi<RPl>, pg8::StaticOrder, false, true>(lds, g2, S, E2, wave); }
        }
#endif
        GRID_BARRIER();
#if EN_PLE
        {
            LAYER_PTRS();
            pg8::StaticOrder S; S.init(MROWS, D, G, (int)blockIdx.x);
            { const bf16_t* Bw = (const bf16_t*)(wl + WO_PG); pg8::Gemm g{hb, Bw, MROWS, D, D}; BigEpi<RPleGate> E{{plb, ss_ple, H_BF16 ? nullptr : hf, hb, hb2, ss_nxt, false}};
              if (SAMPLE_SMALL) small_gemm(hb, Bw, D, D, E.e, wave, G);
              pg8::gemm_phase<BigEpi<RPleGate>, pg8::StaticOrder, true, true>(lds, g, S, E, wave); }
        }
#endif
        GRID_BARRIER();
    }
    {
        ARGS_HERE(); WSPTRS(); LANE_TID(); float* out = ap->out; const float* norm_final = ap->in[25];
        const int gw = blockIdx.x * NWAVES + wave, NGW = G * NWAVES;
        const ss_t* ssf = ssb + (size_t)12 * MT;
        for (int r = gw; r < MT; r += NGW) {
            const float rs = ss_rs(ssf, r);
            float* yr = (r < MP) ? out + O_YP + (size_t)r * D : out + O_YS + (size_t)(r - MP) * D;
#pragma unroll
            for (int j = 0; j < 4; ++j) { const int c = 4 * lane + 256 * j; f32x4 v; if (H_BF16) { const u32x2 w = *(const u32x2*)(hb2 + (size_t)r * D + c); v = (f32x4){bf_lo(w.x), bf_hi(w.x), bf_lo(w.y), bf_hi(w.y)}; } else v = *(const f32x4*)(hf + (size_t)r * D + c);
                const f32x4 gv = *(const f32x4*)(norm_final + c); *(f32x4*)(yr + c) = v * rs * gv; }
        }
    }
}

extern "C" void kernel_launch(void* const* d_in, const int* in_sizes, int n_in, void* d_out, int out_size, void* d_ws, size_t ws_size, hipStream_t stream) {
    static int grid = 0;
    if (grid == 0) {
        if (n_in != 26 || (size_t)out_size != O_END || ws_size < WS_END) { fprintf(stderr, "kernel_launch: unexpected shapes: n_in %d out %d ws %zu (need %zu)\n", n_in, out_size, ws_size, (size_t)WS_END); grid = -1; return; }
        int dev = 0, cus = 0, per_cu = 0;
        if (hipGetDevice(&dev) != hipSuccess || hipDeviceGetAttribute(&cus, hipDeviceAttributeMultiprocessorCount, dev) != hipSuccess) { grid = -1; return; }
        if (hipFuncSetAttribute((const void*)trunk_fwd, hipFuncAttributeMaxDynamicSharedMemorySize, LDS_BYTES) != hipSuccess) { fprintf(stderr, "kernel_launch: hipFuncSetAttribute failed\n"); grid = -1; return; }
        if (hipOccupancyMaxActiveBlocksPerMultiprocessor(&per_cu, (const void*)trunk_fwd, NTHREADS, LDS_BYTES) != hipSuccess || per_cu < 1) { fprintf(stderr, "kernel_launch: occupancy query says %d\n", per_cu); }
        (void)hipGetLastError();
        grid = cus;
    }
    if (grid < 0) return;
    if (hipMemsetAsync((char*)d_ws + WS_CTL, 0, CTL_ZERO_BYTES, stream) != hipSuccess) return;
    Args a{};
    for (int i = 0; i < 26; ++i) a.in[i] = (const float*)d_in[i];
    a.out = (float*)d_out; a.ws = (unsigned char*)d_ws;
    hipLaunchKernelGGL(trunk_fwd, dim3(grid), dim3(NTHREADS), LDS_BYTES, stream, a);
}
```

```cpp
#include <hip/hip_runtime.h>
#include <hip/hip_bf16.h>
#include <cstdio>
#include <cstdint>
#include <cmath>
__device__ __forceinline__ int lane_id_volatile() { int l; asm volatile("v_mbcnt_lo_u32_b32 %0, -1, 0\n\tv_mbcnt_hi_u32_b32 %0, -1, %0" : "=v"(l)); return l; }
namespace pg8 {
#define PG8_LAS __attribute__((address_space(3)))
typedef unsigned short bf16_t;
typedef short bf16x8 __attribute__((ext_vector_type(8)));
typedef float f32x4 __attribute__((ext_vector_type(4)));
typedef unsigned u32x4 __attribute__((ext_vector_type(4)));
constexpr int BM = 256, BK = 64, HALF = 128, HTB = HALF * BK * 2  , STAGE_BYTES = 8 * HTB, NXCD = 8, WGM = 8;

__host__ __device__ __forceinline__ int lds_byte(int r, int c) { const int st = (r >> 4) * 2 + (c >> 5), rr = r & 15, cc = c & 31, ob = rr * 64 + cc * 2; return st * 1024 + (ob ^ (((ob >> 9) & 1) << 5)); }
__host__ __device__ __forceinline__ void stage_rc(int b, int& R, int& C) { const int st = b / 1024, sb = b % 1024, swz = sb ^ (((sb >> 9) & 1) << 5); R = (st >> 1) * 16 + swz / 64; C = (st & 1) * 32 + (swz % 64) / 2; }
__host__ __device__ __forceinline__ int perm32(int rho) { const int n = rho >> 4, i = rho & 15; return 8 * (i >> 2) + 4 * n + (i & 3); }

struct Unit { int pm, pn; };
struct Gemm { const bf16_t* A; const bf16_t* Bt; int M, N, K; };

struct StaticOrder {
    int nM, nN, nwg, G, c;
    __host__ __device__ void init(int M, int N, int G_, int c_) { nM = M / BM; nN = N / BM; nwg = nM * nN; G = G_; c = c_; }
    __host__ __device__ bool next(int i, Unit& u) const {
        const int L = i * G + c; if (L >= nwg) return false;
        int wgid = L; { const int q = nwg / NXCD, r = nwg % NXCD, xcd = wgid % NXCD, off = wgid / NXCD; wgid = (xcd < r ? xcd * (q + 1) : r * (q + 1) + (xcd - r) * q) + off; }
        const int nig = WGM * nN, gid = wgid / nig, fm = gid * WGM, gsz = (nM - fm) < WGM ? (nM - fm) : WGM;
        u.pm = fm + ((wgid % nig) % gsz); u.pn = (wgid % nig) / gsz; return true;
    }
    __device__ __forceinline__ void a_ready(const Unit&) const {}
    __device__ __forceinline__ void done(const Unit&) const {}
};

__device__ __forceinline__ unsigned cvt_pk_bf16(float lo, float hi) { unsigned r; asm volatile("v_cvt_pk_bf16_f32 %0, %1, %2" : "=v"(r) : "v"(lo), "v"(hi)); return r; }
template <class Epi, class Sched, bool ALIGN_EPI = false, bool SP2 = false>
__device__ __forceinline__ void gemm_phase(PG8_LAS unsigned char* lds, const Gemm g, const Sched& S, const Epi& E, const int wave_id  ) {
    int tid_ = wave_id * 64 + lane_id_volatile(); asm volatile("" : "+v"(tid_));
    const int tid = tid_, wid = __builtin_amdgcn_readfirstlane(tid >> 6), lane = tid & 63, wr = wid >> 2, wc = wid & 3, fr = lane & 15, fq = lane >> 4;
    const int K = g.K, nt = K / BK;
    unsigned voffA[2], voffB[2];
#pragma unroll
    for (int i = 0; i < 2; ++i) { int R, C; stage_rc(tid * 16 + i * 8192, R, C); const int Rb = Epi::PERM ? ((R & ~31) + perm32(R & 31)) : R;
        voffA[i] = (unsigned)(R * K + C) * 2u; voffB[i] = (unsigned)(Rb * K + C) * 2u; }
    const size_t kstep = (size_t)(BK * 2);
    const size_t hstep = (size_t)HALF * K * 2;
    const size_t tstep = 2 * hstep;
    const unsigned ldsw = (unsigned)wid * 1024u;
    const int aoff = lds_byte(wr * 64 + fr, fq * 8), boff = lds_byte(wc * 32 + fr, fq * 8);
#define PG8_SA(b, h) (((b) * 2 + (h)) * HTB)
#define PG8_SB(b, h) ((4 + (b) * 2 + (h)) * HTB)
#define PG8_STAGE(bufoff, gbase, voff) do { _Pragma("unroll") for (int _i = 0; _i < 2; ++_i) \
        __builtin_amdgcn_global_load_lds((const unsigned*)((const char*)(gbase) + (voff)[_i]), (PG8_LAS unsigned*)(lds + (bufoff) + ldsw + _i * 8192), 16, 0, 0); } while (0)
#define PG8_LDA(dst, b, h) do { _Pragma("unroll") for (int m = 0; m < 4; ++m) _Pragma("unroll") for (int k = 0; k < 2; ++k) dst[m][k] = *(const PG8_LAS bf16x8*)(lds + PG8_SA(b, h) + aoff + m * 2048 + k * 1024); } while (0)
#define PG8_LDB(dst, b, h) do { _Pragma("unroll") for (int n = 0; n < 2; ++n) _Pragma("unroll") for (int k = 0; k < 2; ++k) dst[n][k] = *(const PG8_LAS bf16x8*)(lds + PG8_SB(b, h) + boff + n * 2048 + k * 1024); } while (0)
#define PG8_MMA(ai, bj, At, Bt) do { __builtin_amdgcn_s_setprio(1); _Pragma("unroll") for (int m = 0; m < 4; ++m) _Pragma("unroll") for (int n = 0; n < 2; ++n) _Pragma("unroll") for (int k = 0; k < 2; ++k) \
        acc[ai][bj][m][n] = __builtin_amdgcn_mfma_f32_16x16x32_bf16(Bt[n][k], At[m][k], acc[ai][bj][m][n], 0, 0, 0); __builtin_amdgcn_s_setprio(0); } while (0)
#define PG8_WAIT_V(n) asm volatile("s_waitcnt vmcnt(" #n ")" ::: "memory")
#define PG8_WAIT_L(n) asm volatile("s_waitcnt lgkmcnt(" #n ")" ::: "memory")
#define PG8_BAR __builtin_amdgcn_s_barrier()
#define PG8_SCHED __builtin_amdgcn_sched_barrier(0)
    Unit cur, nxt; int ui = 0;
    if (!S.next(0, cur)) return;
    f32x4 acc[2][2][4][2];
#pragma unroll
    for (int a = 0; a < 2; ++a)
#pragma unroll
        for (int b = 0; b < 2; ++b)
#pragma unroll
            for (int m = 0; m < 4; ++m)
#pragma unroll
                for (int n = 0; n < 2; ++n) acc[a][b][m][n] = (f32x4){0.f, 0.f, 0.f, 0.f};
    bf16x8 At[4][2], B0[2][2], B1[2][2];
    const char* cA = (const char*)g.A + (size_t)cur.pm * tstep; const char* cB = (const char*)g.Bt + (size_t)cur.pn * tstep;
    S.a_ready(cur);
    if constexpr (SP2) {
        PG8_STAGE(PG8_SB(0, 0), cB, voffB); PG8_STAGE(PG8_SB(0, 1), cB + hstep, voffB); PG8_STAGE(PG8_SA(0, 0), cA, voffA); PG8_STAGE(PG8_SA(0, 1), cA + hstep, voffA);
        if (wr == 1) PG8_BAR;
        PG8_WAIT_V(2); PG8_BAR;
        PG8_STAGE(PG8_SB(1, 0), cB + kstep, voffB); PG8_STAGE(PG8_SA(1, 0), cA + kstep, voffA); PG8_STAGE(PG8_SB(1, 1), cB + hstep + kstep, voffB);
        PG8_WAIT_V(6); PG8_BAR;
    } else {
        PG8_STAGE(PG8_SB(0, 0), cB, voffB); PG8_STAGE(PG8_SA(0, 0), cA, voffA); PG8_STAGE(PG8_SB(0, 1), cB + hstep, voffB); PG8_STAGE(PG8_SA(0, 1), cA + hstep, voffA);
        if (wr == 1) PG8_BAR;
        PG8_WAIT_V(4); PG8_BAR;
        PG8_STAGE(PG8_SB(1, 0), cB + kstep, voffB); PG8_STAGE(PG8_SA(1, 0), cA + kstep, voffA); PG8_STAGE(PG8_SB(1, 1), cB + hstep + kstep, voffB);
        PG8_WAIT_V(6); PG8_BAR;
    }
    for (;;) {
        const bool has_next = S.next(ui + 1, nxt);
        const char* nA = has_next ? (const char*)g.A + (size_t)nxt.pm * tstep : cA; const char* nB = has_next ? (const char*)g.Bt + (size_t)nxt.pn * tstep : cB;
        for (int t = 0; t < nt; t += 2) {
            const bool last = (t == nt - 2);
            const char* a1 = cA + (size_t)(t + 1) * kstep;
            const char* a2 = last ? nA : cA + (size_t)(t + 2) * kstep; const char* b2 = last ? nB : cB + (size_t)(t + 2) * kstep;
            const char* a3 = a2 + kstep; const char* b3 = b2 + kstep;
            if (last && has_next) S.a_ready(nxt);
            if constexpr (SP2) {
            PG8_LDB(B0, 0, 0); PG8_LDB(B1, 0, 1); PG8_SCHED; PG8_LDA(At, 0, 0); PG8_STAGE(PG8_SA(1, 1), a1 + hstep, voffA);
            PG8_WAIT_V(8); PG8_WAIT_L(0); PG8_BAR; PG8_MMA(0, 0, At, B0); PG8_MMA(0, 1, At, B1); PG8_BAR; PG8_SCHED;
            PG8_LDA(At, 0, 1); PG8_STAGE(PG8_SB(0, 0), b2, voffB); PG8_STAGE(PG8_SB(0, 1), b2 + hstep, voffB); PG8_STAGE(PG8_SA(0, 0), a2, voffA);
            PG8_WAIT_V(8); PG8_WAIT_L(0); PG8_BAR; PG8_MMA(1, 0, At, B0); PG8_MMA(1, 1, At, B1); PG8_BAR; PG8_SCHED;
            PG8_LDB(B0, 1, 0); PG8_LDB(B1, 1, 1); PG8_SCHED; PG8_LDA(At, 1, 0); PG8_STAGE(PG8_SA(0, 1), a2 + hstep, voffA);
            PG8_WAIT_V(8); PG8_WAIT_L(0); PG8_BAR; PG8_MMA(0, 0, At, B0); PG8_MMA(0, 1, At, B1); PG8_BAR; PG8_SCHED;
            PG8_LDA(At, 1, 1); PG8_STAGE(PG8_SB(1, 0), b3, voffB); PG8_STAGE(PG8_SB(1, 1), b3 + hstep, voffB); PG8_STAGE(PG8_SA(1, 0), a3, voffA);
            PG8_WAIT_V(8); PG8_WAIT_L(0); PG8_BAR; PG8_MMA(1, 0, At, B0); PG8_MMA(1, 1, At, B1); PG8_BAR; PG8_SCHED;
            } else {
            PG8_LDB(B0, 0, 0); PG8_SCHED; PG8_LDA(At, 0, 0); PG8_STAGE(PG8_SA(1, 1), a1 + hstep, voffA);
            PG8_WAIT_L(8); PG8_BAR; PG8_WAIT_L(0); PG8_MMA(0, 0, At, B0); PG8_BAR; PG8_SCHED;
            PG8_LDB(B1, 0, 1); PG8_STAGE(PG8_SB(0, 0), b2, voffB);
            PG8_BAR; PG8_WAIT_L(0); PG8_MMA(0, 1, At, B1); PG8_BAR;
            PG8_LDA(At, 0, 1); PG8_STAGE(PG8_SA(0, 0), a2, voffA);
            PG8_BAR; PG8_WAIT_L(0); PG8_MMA(1, 0, At, B0); PG8_BAR; PG8_SCHED;
            PG8_STAGE(PG8_SB(0, 1), b2 + hstep, voffB);
            PG8_WAIT_V(6); PG8_BAR; PG8_MMA(1, 1, At, B1); PG8_BAR;
            PG8_LDB(B0, 1, 0); PG8_SCHED; PG8_LDA(At, 1, 0); PG8_STAGE(PG8_SA(0, 1), a2 + hstep, voffA);
            PG8_WAIT_L(8); PG8_BAR; PG8_WAIT_L(0); PG8_MMA(0, 0, At, B0); PG8_BAR; PG8_SCHED;
            PG8_LDB(B1, 1, 1); PG8_STAGE(PG8_SB(1, 0), b3, voffB);
            PG8_BAR; PG8_WAIT_L(0); PG8_MMA(0, 1, At, B1); PG8_BAR;
            PG8_LDA(At, 1, 1); PG8_STAGE(PG8_SA(1, 0), a3, voffA);
            PG8_BAR; PG8_WAIT_L(0); PG8_MMA(1, 0, At, B0); PG8_BAR; PG8_SCHED;
            PG8_STAGE(PG8_SB(1, 1), b3 + hstep, voffB);
            PG8_WAIT_V(6); PG8_BAR; PG8_MMA(1, 1, At, B1); PG8_BAR;
            }
        }
        if constexpr (ALIGN_EPI) { if (wr == 0) PG8_BAR; }
        if constexpr (!Epi::AFTER_DRAIN) { E(acc, cur, wr, wc, fr, fq); S.done(cur); }
        if (!has_next) break;
#pragma unroll
        for (int a = 0; a < 2; ++a)
#pragma unroll
            for (int b = 0; b < 2; ++b)
#pragma unroll
                for (int m = 0; m < 4; ++m)
#pragma unroll
                    for (int n = 0; n < 2; ++n) acc[a][b][m][n] = (f32x4){0.f, 0.f, 0.f, 0.f};
        cur = nxt; cA = nA; cB = nB; ++ui;
        if constexpr (ALIGN_EPI) { if (wr == 1) PG8_BAR; }
    }
    PG8_WAIT_V(0);
    if constexpr (!ALIGN_EPI) { if (wr == 0) PG8_BAR; }
    PG8_BAR;
    if constexpr (Epi::AFTER_DRAIN) { E.fused(acc, cur, wr, wc, fr, fq, lds, wid, lane); S.done(cur); }
#undef PG8_SA
#undef PG8_SB
#undef PG8_STAGE
#undef PG8_LDA
#undef PG8_LDB
#undef PG8_MMA
#undef PG8_WAIT_V
#undef PG8_WAIT_L
#undef PG8_BAR
#undef PG8_SCHED
}
}
#define LAS __attribute__((address_space(3)))
#define GAS __attribute__((address_space(1)))
typedef unsigned short bf16_t;
typedef short bf16x8 __attribute__((ext_vector_type(8)));
typedef short s16x4 __attribute__((ext_vector_type(4)));
typedef float f32x4 __attribute__((ext_vector_type(4)));
typedef float f32x16 __attribute__((ext_vector_type(16)));
typedef unsigned u32x4 __attribute__((ext_vector_type(4)));
typedef unsigned u32x2 __attribute__((ext_vector_type(2)));
typedef float f32x2_t __attribute__((ext_vector_type(2)));
typedef __bf16 bf16x2_t __attribute__((ext_vector_type(2)));

constexpr int D = 1024, MP = 32768, MS = 1024, MT = MP + MS, SEQ = 8192, NLAYER = 4;
constexpr int FFN = 2816, NGU = 2 * FFN, PLE = 256, NQKV = 3072;
constexpr float EPS = 1e-6f;
constexpr float LOG2E = 1.4426950408889634f;
constexpr float C2 = 0.125f * LOG2E;

constexpr size_t O_YP = 0, O_YS = O_YP + (size_t)MP * D, O_SBKP = O_YS + (size_t)MS * D, O_SBVP = O_SBKP + 2ull * MP * 512, O_DFKP = O_SBVP + 2ull * MP * 512,
                 O_DFVP = O_DFKP + 2ull * MP * 512, O_BDKP = O_DFVP + 2ull * MP * 512, O_BDVP = O_BDKP + 2ull * 4 * 512 * 1024, O_SBKS = O_BDVP + 2ull * 4 * 512 * 1024,
                 O_SBVS = O_SBKS + 2ull * MS * 512, O_DFKS = O_SBVS + 2ull * MS * 512, O_DFVS = O_DFKS + 2ull * MS * 512, O_BDKS = O_DFVS + 2ull * MS * 512,
                 O_BDVS = O_BDKS + 2ull * MS * 1024, O_END = O_BDVS + 2ull * MS * 1024;
static_assert(O_END == 185597952ull, "output size");

constexpr size_t MiB = 1u << 20;
constexpr size_t WS_CTL = 0, CTL_ZERO_BYTES = 5 * MiB;
constexpr int CW_BAR = 4096;
constexpr int CW_QUEUE = 8192;
constexpr int CW_CHAIN = 16384;
constexpr size_t WS_SS = 1 * MiB;
static_assert(WS_SS + 13ull * MT * 8 <= CTL_ZERO_BYTES, "ss inside memset region");
typedef unsigned long long ss_t;
constexpr float SS_SCALE = 1048576.0f, SS_INV = 1.0f / 1048576.0f;
__device__ __forceinline__ float ss_rs(const ss_t* ss, int r);
constexpr size_t WS_ROPEC = 5 * MiB, WS_ROPES = 6 * MiB, WS_LAM = 7 * MiB;
constexpr size_t WS_W = 8 * MiB, W_LAYER = 27 * MiB;
constexpr size_t WO_IN = 0, WO_OUT = WO_IN + (size_t)NQKV * D * 2, WO_GU = WO_OUT + (size_t)D * D * 2, WO_DN = WO_GU + (size_t)NGU * D * 2, WO_PG = WO_DN + (size_t)D * FFN * 2,
                 WO_PL = WO_PG + (size_t)D * D * 2, WO_END = WO_PL + (size_t)D * PLE * 2;
static_assert(WO_END == W_LAYER, "weights per layer");
constexpr size_t WS_H = 116 * MiB;
constexpr size_t WS_HB = 248 * MiB;
constexpr size_t WS_QKV = 314 * MiB;
constexpr size_t WS_O = 512 * MiB;
constexpr size_t WS_PL = 578 * MiB;
constexpr size_t WS_PB = 644 * MiB;
constexpr size_t WS_HB2 = 710 * MiB;
constexpr size_t WS_ACT = 776 * MiB;
constexpr size_t WS_END = 958 * MiB;
static_assert(WS_W + 4 * W_LAYER <= WS_H && WS_H + (size_t)MT * D * 4 <= WS_HB && WS_HB + (size_t)MT * D * 2 <= WS_QKV && WS_QKV + (size_t)MT * NQKV * 2 <= WS_O &&
              WS_O + (size_t)MT * D * 2 <= WS_PL && WS_PL + (size_t)MT * D * 2 <= WS_PB && WS_PB + 4ull * MT * PLE * 2 <= WS_HB2 && WS_HB2 + (size_t)MT * D * 2 <= WS_ACT && WS_ACT + (size_t)MT * FFN * 2 <= WS_END, "ws map");

constexpr int ATT_BIAS_OFF = 139264, LDSCTL_OFF = 147456, LDS_BYTES = 147456 + 512;
constexpr int NWAVES = 8, NTHREADS = 512;

#define LDS_WAIT() asm volatile("s_waitcnt lgkmcnt(0)" ::: "memory")
#define VM_WAIT() asm volatile("s_waitcnt vmcnt(0)" ::: "memory")

__device__ __forceinline__ unsigned cvtpk(float lo, float hi) { f32x2_t v = {lo, hi}; bf16x2_t b = __builtin_convertvector(v, bf16x2_t); return __builtin_bit_cast(unsigned, b); }
__device__ __forceinline__ float ss_rs(const ss_t* ss, int r) { return rsqrtf((float)ss[r] * (SS_INV / D) + EPS); }
__device__ __forceinline__ void ss_add(ss_t* ss, int r, float ps) { atomicAdd(ss + r, (ss_t)__float2ull_rn(ps * SS_SCALE)); }
__device__ __forceinline__ void st16(void* p, u32x4 v, bool wt) { if (wt) asm volatile("global_store_dwordx4 %0, %1, off sc1\n\ts_nop 2" :: "v"(p), "v"(v) : "memory");     else *(u32x4*)p = v; }
__device__ __forceinline__ void st8(void* p, u32x2 v, bool wt) { if (wt) asm volatile("global_store_dwordx2 %0, %1, off sc1\n\ts_nop 2" :: "v"(p), "v"(v) : "memory"); else *(u32x2*)p = v; }
__device__ __forceinline__ float bf_lo(unsigned w) { return __uint_as_float(w << 16); }
__device__ __forceinline__ float bf_hi(unsigned w) { return __uint_as_float(w & 0xffff0000u); }
__device__ __forceinline__ u32x4 pack8(f32x4 a, f32x4 b) { u32x4 w; w.x = cvtpk(a[0], a[1]); w.y = cvtpk(a[2], a[3]); w.z = cvtpk(b[0], b[1]); w.w = cvtpk(b[2], b[3]); return w; }
__device__ __forceinline__ float sum_x16_x32(float v) {
    auto a = __builtin_amdgcn_permlane16_swap(__float_as_uint(v), __float_as_uint(v), false, false); v = __uint_as_float(a[0]) + __uint_as_float(a[1]);
    auto b = __builtin_amdgcn_permlane32_swap(__float_as_uint(v), __float_as_uint(v), false, false); return __uint_as_float(b[0]) + __uint_as_float(b[1]);
}
__device__ __forceinline__ float wave_sum(float v) {
#pragma unroll
    for (int o = 1; o < 64; o <<= 1) v += __shfl_xor(v, o);
    return v;
}

#ifndef H_BF16
#define H_BF16 1
#endif
using pg8::Unit;
#define UNI(x) __builtin_amdgcn_readfirstlane(x)
template <bool WT> struct RQkvEvenT {
    static constexpr bool NEED_RS = true, NEED_SS = false;
    bf16_t* qkv; const ss_t* ss; const float* ropec; const float* ropes; float* out; int e; ss_t* ssn; bool wt;
    __device__ __forceinline__ float rs_of(int r) const { return ss_rs(ss, r); }
    static constexpr int PFM = 1;
    struct Pre { f32x4 cs, sn; };
    __device__ __forceinline__ Pre pre(int r, int c) const {
        Pre p; const int region = UNI(c >> 9), cl = c & 511;
        if (region == 3 || region == 4) { const bool sample = UNI(r >= MP); const int pos = sample ? 1024 + (r & 31) : (r & (SEQ - 1)); const int i0 = 16 * ((cl >> 5) & 1) + 4 * ((cl >> 3) & 3);
            p.cs = *(const f32x4*)(ropec + pos * 32 + i0); p.sn = *(const f32x4*)(ropes + pos * 32 + i0); }
        return p; }
    __device__ __forceinline__ float row8(int r, int c, const f32x4 a0, const f32x4 a1, float rs) const { return row8(r, c, a0, a1, rs, pre(r, c)); }
    __device__ __forceinline__ float row8(int r, int c, const f32x4 a0, const f32x4 a1, float rs, const Pre& pr) const {
        const int region = UNI(c >> 9), cl = c & 511;
        const bool sample = UNI(r >= MP);
        float* ob = nullptr;
        if (region == 1) ob = out + (sample ? O_SBKS + (size_t)e * MS * 512 : O_SBKP + (size_t)e * MP * 512);
        else if (region == 2) ob = out + (sample ? O_SBVS + (size_t)e * MS * 512 : O_SBVP + (size_t)e * MP * 512);
        else if (region == 4) ob = out + (sample ? O_DFKS + (size_t)e * MS * 512 : O_DFKP + (size_t)e * MP * 512);
        else if (region == 5) ob = out + (sample ? O_DFVS + (size_t)e * MS * 512 : O_DFVP + (size_t)e * MP * 512);
        const float qs = (region == 0 || region == 3) ? C2 : 1.0f;
        const int tok = sample ? r - MP : r;
        bf16_t* qrow = qkv + (size_t)r * NQKV + region * 512;
        if (region == 3 || region == 4) {
            const int pos = sample ? 1024 + (r & 31) : (r & (SEQ - 1));
            const int i0 = 16 * ((cl >> 5) & 1) + 4 * ((cl >> 3) & 3), lc = (cl & ~63) + i0;
            const f32x4 cs = pr.cs, sn = pr.sn; (void)pos;
            const f32x4 x1 = a0 * rs, x2 = a1 * rs;
            const f32x4 o1 = x1 * cs - x2 * sn, o2 = x2 * cs + x1 * sn;
            u32x2 w1, w2; w1.x = cvtpk(o1[0] * qs, o1[1] * qs); w1.y = cvtpk(o1[2] * qs, o1[3] * qs); w2.x = cvtpk(o2[0] * qs, o2[1] * qs); w2.y = cvtpk(o2[2] * qs, o2[3] * qs);
            st8(qrow + lc, w1, WT); st8(qrow + lc + 32, w2, WT);
            if (ob) { float* op = ob + (size_t)tok * 512 + lc; __builtin_nontemporal_store(o1, (f32x4*)op); __builtin_nontemporal_store(o2, (f32x4*)(op + 32)); }
        } else {
            const f32x4 v0 = a0 * rs, v1 = a1 * rs;
            st16(qrow + cl, pack8(v0 * qs, v1 * qs), WT);
            if (ob) { float* op = ob + (size_t)tok * 512 + cl; __builtin_nontemporal_store(v0, (f32x4*)op); __builtin_nontemporal_store(v1, (f32x4*)(op + 4)); }
        }
        return 0.f;
    }
};
template <bool WT> struct RQkvOddT {
    static constexpr bool NEED_RS = true, NEED_SS = false;
    bf16_t* qkv; const ss_t* ss; float* out; int od; ss_t* ssn; bool wt;
    __device__ __forceinline__ float rs_of(int r) const { return ss_rs(ss, r); }
    static constexpr int PFM = 4; struct Pre {}; __device__ __forceinline__ Pre pre(int, int) const { return Pre{}; }
    __device__ __forceinline__ float row8(int r, int c, const f32x4 a0, const f32x4 a1, float rs, const Pre&) const { return row8(r, c, a0, a1, rs); }
    __device__ __forceinline__ float row8(int r, int c, const f32x4 a0, const f32x4 a1, float rs) const {
        const int region = UNI(c >> 10), cl = c & 1023;
        const bool sample = UNI(r >= MP);
        const bool keep = sample || UNI((r & (SEQ - 1)) >= 7680);
        float* ob = nullptr;
        if (keep && region == 1) ob = out + (sample ? O_BDKS + (size_t)od * MS * 1024 : O_BDKP + (size_t)od * 4 * 512 * 1024);
        else if (keep && region == 2) ob = out + (sample ? O_BDVS + (size_t)od * MS * 1024 : O_BDVP + (size_t)od * 4 * 512 * 1024);
        const float qs = (region == 0) ? C2 : 1.0f;
        const int tok = sample ? r - MP : (r >> 13) * 512 + ((r & (SEQ - 1)) - 7680);
        const f32x4 v0 = a0 * rs, v1 = a1 * rs;
        st16(qkv + (size_t)r * NQKV + region * 1024 + cl, pack8(v0 * qs, v1 * qs), WT);
        if (ob) { float* op = ob + (size_t)tok * 1024 + cl; __builtin_nontemporal_store(v0, (f32x4*)op); __builtin_nontemporal_store(v1, (f32x4*)(op + 4)); }
        return 0.f;
    }
};
__device__ __forceinline__ float sumsq8(const f32x4 v0, const f32x4 v1) { return (v0[0] * v0[0] + v0[1] * v0[1]) + (v0[2] * v0[2] + v0[3] * v0[3]) + (v1[0] * v1[0] + v1[1] * v1[1]) + (v1[2] * v1[2] + v1[3] * v1[3]); }
template <bool WT> struct RResidT {
    static constexpr bool NEED_RS = false, NEED_SS = true;
    const float* resP; const float* resS; const bf16_t* resB; float* h; bf16_t* hb; ss_t* ssn; bool wt;
    __device__ __forceinline__ float rs_of(int) const { return 1.0f; }
    static constexpr int PFM = 4;
    struct Pre { u32x4 a; };
    __device__ __forceinline__ Pre pre(int r, int c) const {
        Pre p; p.a = *(const u32x4*)(resB + (size_t)r * D + c); return p; }
    __device__ __forceinline__ float row8(int r, int c, const f32x4 a0, const f32x4 a1, float rs) const { return row8(r, c, a0, a1, rs, pre(r, c)); }
    __device__ __forceinline__ float row8(int r, int c, const f32x4 a0, const f32x4 a1, float, const Pre& pr) const {
        f32x4 v0, v1;
        { const u32x4 w = pr.a; v0 = a0 + (f32x4){bf_lo(w.x), bf_hi(w.x), bf_lo(w.y), bf_hi(w.y)}; v1 = a1 + (f32x4){bf_lo(w.z), bf_hi(w.z), bf_lo(w.w), bf_hi(w.w)}; }
        if (!H_BF16 && h) { *(f32x4*)(h + (size_t)r * D + c) = v0; *(f32x4*)(h + (size_t)r * D + c + 4) = v1; }
        st16(hb + (size_t)r * D + c, pack8(v0, v1), WT);
        return sumsq8(v0, v1);
    }
};
template <bool WT> struct RGateUpT {
    static constexpr bool NEED_RS = true, NEED_SS = false;
    bf16_t* act; const ss_t* ss; ss_t* ssn; bool wt;
    __device__ __forceinline__ float rs_of(int r) const { return ss_rs(ss, r); }
    static constexpr int PFM = 4; struct Pre {}; __device__ __forceinline__ Pre pre(int, int) const { return Pre{}; }
    __device__ __forceinline__ float row8(int r, int c, const f32x4 a0, const f32x4 a1, float rs, const Pre&) const { return row8(r, c, a0, a1, rs); }
    __device__ __forceinline__ float row8(int r, int c, const f32x4 a0, const f32x4 a1, float rs) const {
        const f32x4 g = a0 * rs, up = a1 * rs;
        float a[4];
#pragma unroll
        for (int j = 0; j < 4; ++j) a[j] = g[j] * __builtin_amdgcn_rcpf(1.0f + __builtin_amdgcn_exp2f(-g[j] * LOG2E)) * up[j];
        u32x2 w; w.x = cvtpk(a[0], a[1]); w.y = cvtpk(a[2], a[3]);
        const auto sx = __builtin_amdgcn_permlane16_swap(w.x, w.x, false, false); const auto sy = __builtin_amdgcn_permlane16_swap(w.y, w.y, false, false);
        if (!((lane_id_volatile() >> 4) & 1)) { const u32x4 w4 = {w.x, w.y, sx[1], sy[1]}; st16(act + (size_t)r * FFN + (c >> 1), w4, WT); }
        return 0.f;
    }
};
template <bool WT> struct RPlT {
    static constexpr bool NEED_RS = false, NEED_SS = false;
    bf16_t* pl; ss_t* ssn; bool wt;
    __device__ __forceinline__ float rs_of(int) const { return 1.0f; }
    static constexpr int PFM = 4; struct Pre {}; __device__ __forceinline__ Pre pre(int, int) const { return Pre{}; }
    __device__ __forceinline__ float row8(int r, int c, const f32x4 a0, const f32x4 a1, float rs, const Pre&) const { return row8(r, c, a0, a1, rs); }
    __device__ __forceinline__ float row8(int r, int c, const f32x4 a0, const f32x4 a1, float) const { st16(pl + (size_t)r * D + c, pack8(a0, a1), WT); return 0.f; }
};
template <bool WT> struct RPleGateT {
    static constexpr bool NEED_RS = true, NEED_SS = true;
    const bf16_t* pl; const ss_t* ss; float* h; const bf16_t* hbin; bf16_t* hb; ss_t* ssn; bool wt;
    __device__ __forceinline__ float rs_of(int r) const { return ss_rs(ss, r); }
    static constexpr int PFM = 2;
    struct Pre { u32x4 pw, hw; };
    __device__ __forceinline__ Pre pre(int r, int c) const { Pre p; p.pw = *(const u32x4*)(pl + (size_t)r * D + c); p.hw = *(const u32x4*)(hbin + (size_t)r * D + c); return p; }
    __device__ __forceinline__ float row8(int r, int c, const f32x4 a0, const f32x4 a1, float rs) const { return row8(r, c, a0, a1, rs, pre(r, c)); }
    __device__ __forceinline__ float row8(int r, int c, const f32x4 a0, const f32x4 a1, float rs, const Pre& pr) const {
        u32x4 wo; float ps = 0.f;
#pragma unroll
        for (int hf_ = 0; hf_ < 2; ++hf_) {
            const f32x4 a = hf_ ? a1 : a0;
            const u32x2 pw = hf_ ? (u32x2){pr.pw.z, pr.pw.w} : (u32x2){pr.pw.x, pr.pw.y};
            f32x4 v;
            if (!H_BF16 && h) v = *(const f32x4*)(h + (size_t)r * D + c + 4 * hf_);
            else { const u32x2 w = hf_ ? (u32x2){pr.hw.z, pr.hw.w} : (u32x2){pr.hw.x, pr.hw.y}; v = (f32x4){bf_lo(w.x), bf_hi(w.x), bf_lo(w.y), bf_hi(w.y)}; }
            const f32x4 p = {bf_lo(pw.x), bf_hi(pw.x), bf_lo(pw.y), bf_hi(pw.y)};
#pragma unroll
            for (int j = 0; j < 4; ++j) v[j] += p[j] * __builtin_amdgcn_rcpf(1.0f + __builtin_amdgcn_exp2f(-a[j] * rs * LOG2E));
            if (!H_BF16 && h) *(f32x4*)(h + (size_t)r * D + c + 4 * hf_) = v;
            ps += (v[0] * v[0] + v[1] * v[1]) + (v[2] * v[2] + v[3] * v[3]);
            if (hf_) { wo.z = cvtpk(v[0], v[1]); wo.w = cvtpk(v[2], v[3]); } else { wo.x = cvtpk(v[0], v[1]); wo.y = cvtpk(v[2], v[3]); }
        }
        st16(hb + (size_t)r * D + c, wo, WT);
        return ps;
    }
};
using RQkvEven = RQkvEvenT<false>;
using RQkvOdd = RQkvOddT<false>;
using RResid = RResidT<false>;
using RGateUp = RGateUpT<false>;
using RPl = RPlT<false>;
using RPleGate = RPleGateT<false>;
template <class RE, bool HOIST = false> struct BigEpi {
    static constexpr bool PERM = true, AFTER_DRAIN = false;
    RE e;
    __device__ __forceinline__ void operator()(const f32x4 (&acc)[2][2][4][2], const Unit& u, int wr, int wc, int fr, int fq) const {
        { const int l_ = lane_id_volatile(); fr = l_ & 15; fq = l_ >> 4; }
        const int row0 = u.pm * 256 + wr * 64 + fr;
        if (!HOIST) {
#pragma unroll
            for (int ai = 0; ai < 2; ++ai)
#pragma unroll
                for (int m = 0; m < 4; ++m) {
                    const int r = row0 + ai * 128 + m * 16;
                    const float rs = RE::NEED_RS ? e.rs_of(r) : 1.0f;
                    float ps = 0.f;
#pragma unroll
                    for (int bj = 0; bj < 2; ++bj) ps += e.row8(r, u.pn * 256 + bj * 128 + wc * 32 + 8 * fq, acc[ai][bj][m][0], acc[ai][bj][m][1], rs);
                    if (RE::NEED_SS) { ps = sum_x16_x32(ps); if (fq == 0 && e.ssn) ss_add(e.ssn, r, ps); }
                }
            return;
        }
        float rsv[2][4];
#pragma unroll
        for (int ai = 0; ai < 2; ++ai)
#pragma unroll
            for (int m = 0; m < 4; ++m) rsv[ai][m] = RE::NEED_RS ? e.rs_of(row0 + ai * 128 + m * 16) : 1.0f;
        constexpr int PFM = RE::PFM;
#pragma unroll
        for (int ai = 0; ai < 2; ++ai)
#pragma unroll
          for (int m0 = 0; m0 < 4; m0 += PFM) {
            typename RE::Pre pre[PFM][2];
#pragma unroll
            for (int m = 0; m < PFM; ++m)
#pragma unroll
                for (int bj = 0; bj < 2; ++bj) pre[m][bj] = e.pre(row0 + ai * 128 + (m0 + m) * 16, u.pn * 256 + bj * 128 + wc * 32 + 8 * fq);
#pragma unroll
            for (int m = m0; m < m0 + PFM; ++m) {
                const int r = row0 + ai * 128 + m * 16;
                float ps = 0.f;
#pragma unroll
                for (int bj = 0; bj < 2; ++bj) ps += e.row8(r, u.pn * 256 + bj * 128 + wc * 32 + 8 * fq, acc[ai][bj][m][0], acc[ai][bj][m][1], rsv[ai][m], pre[m - m0][bj]);
                if (RE::NEED_SS) { ps = sum_x16_x32(ps); if (fq == 0 && e.ssn) ss_add(e.ssn, r, ps); }
            }
          }
    }
};
struct RAny {
    static constexpr bool NEED_RS = true, NEED_SS = true;
    int kind;
    int L;
    unsigned char* ws; float* out; const float* x_sample; ss_t* ssn;
    __device__ __forceinline__ const ss_t* ssp(int k) const { return (const ss_t*)(ws + WS_SS) + (size_t)(3 * L + k) * MT; }
    __device__ __forceinline__ float rs_of(int r) const {
        if (kind <= 1) return ss_rs(ssp(0), r);
        if (kind == 3) return ss_rs(ssp(1), r);
        if (kind == 6) return ss_rs(ssp(2), r);
        return 1.0f;
    }
    __device__ __forceinline__ float row8(int r, int c, const f32x4 a0, const f32x4 a1, float rs) const {
        bf16_t* hb = (bf16_t*)(ws + WS_HB); bf16_t* hb2 = (bf16_t*)(ws + WS_HB2); bf16_t* plb = (bf16_t*)(ws + WS_PL);
        switch (kind) {
            case 0: { const RQkvEvenT<true> q{(bf16_t*)(ws + WS_QKV), ssp(0), (const float*)(ws + WS_ROPEC), (const float*)(ws + WS_ROPES), out, L >> 1, nullptr, true}; return q.row8(r, c, a0, a1, rs); }
            case 1: { const RQkvOddT<true> q{(bf16_t*)(ws + WS_QKV), ssp(0), out, L >> 1, nullptr, true}; return q.row8(r, c, a0, a1, rs); }
            case 2: { const RResidT<true> q{nullptr, x_sample, hb2, nullptr, hb, nullptr, true}; return q.row8(r, c, a0, a1, rs); }
            case 3: { const RGateUpT<true> q{(bf16_t*)(ws + WS_ACT), ssp(1), nullptr, true}; return q.row8(r, c, a0, a1, rs); }
            case 4: { const RResidT<true> q{nullptr, nullptr, hb, nullptr, hb, nullptr, true}; return q.row8(r, c, a0, a1, rs); }
            case 5: { const RPlT<true> q{plb, nullptr, true}; return q.row8(r, c, a0, a1, rs); }
            default: { const RPleGateT<true> q{plb, ssp(2), nullptr, hb, hb2, nullptr, true}; return q.row8(r, c, a0, a1, rs); }
        }
    }
};
struct AnyEpi {
    static constexpr bool PERM = true, AFTER_DRAIN = false;
    int kind, L; unsigned char* ws; float* out; const float* x_sample; ss_t* ssn;
    __device__ __forceinline__ const ss_t* ssp(int k) const { return (const ss_t*)(ws + WS_SS) + (size_t)(3 * L + k) * MT; }
    __device__ __forceinline__ void operator()(const f32x4 (&acc)[2][2][4][2], const Unit& u, int wr, int wc, int fr, int fq) const {
        bf16_t* hb = (bf16_t*)(ws + WS_HB); bf16_t* hb2 = (bf16_t*)(ws + WS_HB2); bf16_t* plb = (bf16_t*)(ws + WS_PL);
        switch (kind) {
            case 0: { const BigEpi<RQkvEvenT<true>, true> q{{(bf16_t*)(ws + WS_QKV), ssp(0), (const float*)(ws + WS_ROPEC), (const float*)(ws + WS_ROPES), out, L >> 1, nullptr, true}}; q(acc, u, wr, wc, fr, fq); break; }
            case 1: { const BigEpi<RQkvOddT<true>, true> q{{(bf16_t*)(ws + WS_QKV), ssp(0), out, L >> 1, nullptr, true}}; q(acc, u, wr, wc, fr, fq); break; }
            case 2: { const BigEpi<RResidT<true>, true> q{{nullptr, x_sample, hb2, nullptr, hb, ssn, true}}; q(acc, u, wr, wc, fr, fq); break; }
            case 3: { const BigEpi<RGateUpT<true>, true> q{{(bf16_t*)(ws + WS_ACT), ssp(1), nullptr, true}}; q(acc, u, wr, wc, fr, fq); break; }
            case 4: { const BigEpi<RResidT<true>, true> q{{nullptr, nullptr, hb, nullptr, hb, ssn, true}}; q(acc, u, wr, wc, fr, fq); break; }
            case 5: { const BigEpi<RPlT<true>, true> q{{plb, nullptr, true}}; q(acc, u, wr, wc, fr, fq); break; }
            default: { const BigEpi<RPleGateT<true>, true> q{{plb, ssp(2), nullptr, hb, hb2, ssn, true}}; q(acc, u, wr, wc, fr, fq); break; }
        }
    }
};
namespace pg8 {
struct OneUnit {
    Unit u;
    __device__ __forceinline__ bool next(int i, Unit& o) const { if (i) return false; o = u; return true; }
    __device__ __forceinline__ void a_ready(const Unit&) const {}
    __device__ __forceinline__ void done(const Unit&) const {}
};
}
template <class RE> __device__ __forceinline__ void small_gemm(const bf16_t* A, const bf16_t* Bt, int N, int K, const RE& e, int wave, int G) {
    const int lane = lane_id_volatile(), fr = lane & 15, fq = lane >> 4, w4 = wave >> 1, w2 = wave & 1;
    const int nunit = 16 * (N / 64);
    for (int u = blockIdx.x; u < nunit; u += G) {
        const int rt = u & 15, ct = u >> 4;
        const int r = MP + 64 * rt + 16 * w4 + fr, c = 64 * ct + 32 * w2 + 8 * fq;
        const bf16_t* ap = A + (size_t)r * K + 8 * fq;
        const bf16_t* bp0 = Bt + (size_t)(64 * ct + 32 * w2 + 8 * (fr >> 2) + (fr & 3)) * K + 8 * fq;
        const bf16_t* bp1 = bp0 + (size_t)4 * K;
        f32x4 c0 = {0.f, 0.f, 0.f, 0.f}, c1 = {0.f, 0.f, 0.f, 0.f};
        for (int k0 = 0; k0 < K; k0 += 256) {
            bf16x8 av[8], b0v[8], b1v[8];
#pragma unroll
            for (int i = 0; i < 8; ++i) { av[i] = *(const bf16x8*)(ap + k0 + 32 * i); b0v[i] = *(const bf16x8*)(bp0 + k0 + 32 * i); b1v[i] = *(const bf16x8*)(bp1 + k0 + 32 * i); }
#pragma unroll
            for (int i = 0; i < 8; ++i) { c0 = __builtin_amdgcn_mfma_f32_16x16x32_bf16(b0v[i], av[i], c0, 0, 0, 0); c1 = __builtin_amdgcn_mfma_f32_16x16x32_bf16(b1v[i], av[i], c1, 0, 0, 0); }
        }
        const float rs = RE::NEED_RS ? e.rs_of(r) : 1.0f;
        float ps = e.row8(r, c, c0, c1, rs);
        if (RE::NEED_SS) { ps = sum_x16_x32(ps); if (fq == 0) ss_add(e.ssn, r, ps); }
    }
    asm volatile("s_waitcnt vmcnt(0)" ::: "memory");
}
namespace att {
constexpr int KSUB = 64 * 144, VSUB = 8192;
enum { SB = 0, DIFF = 1, BAND = 2 };
template <int MODE> struct Geo;
template <> struct Geo<SB>   { static constexpr int NKS = 1, NVS = 1, NDB = 2; };
template <> struct Geo<DIFF> { static constexpr int NKS = 2, NVS = 2, NDB = 4; };
template <> struct Geo<BAND> { static constexpr int NKS = 4, NVS = 4, NDB = 2; };

struct Params {
    const bf16_t* qkv; bf16_t* o;
    const float* cK; const float* cV;
    const float* gain;
    const float* bias;
    const float* lamp;
};
struct TileSrc { const void* k; const void* v; int pitch; int f32; int nvalid; };

__device__ __forceinline__ int kpi(int m) { return ((m >> 2) & 1) * 16 + (m >> 3) * 4 + (m & 3); }
__device__ __forceinline__ s16x4 vtr(const LAS char* p) { typedef short v4i16_t __attribute__((ext_vector_type(4))); return __builtin_bit_cast(s16x4, __builtin_amdgcn_ds_read_tr16_b64_v4i16((LAS v4i16_t*)p)); }
__device__ __forceinline__ float swap_lo(float x, float& hi_out) { auto rr = __builtin_amdgcn_permlane32_swap(__float_as_uint(x), __float_as_uint(x), false, false); hi_out = __uint_as_float(rr[1]); return __uint_as_float(rr[0]); }

template <int NKS, int NVS> __device__ __forceinline__ void tile_load(u32x4 (&kr)[NKS], u32x4 (&vr)[NVS], const TileSrc& s, int key, int ch) {
    const bool ok = key < s.nvalid;
    const u32x4 z = {0u, 0u, 0u, 0u};
    if (s.f32) {
        const float* kp = (const float*)s.k + (size_t)key * s.pitch + ch * 8;
        const float* vp = (const float*)s.v + (size_t)key * s.pitch + ch * 8;
        f32x4 ta[NKS][2], tb[NVS][2];
#pragma unroll
        for (int i = 0; i < NKS; ++i) { ta[i][0] = *(const f32x4*)(kp + i * 64); ta[i][1] = *(const f32x4*)(kp + i * 64 + 4); }
#pragma unroll
        for (int i = 0; i < NVS; ++i) { tb[i][0] = *(const f32x4*)(vp + i * 64); tb[i][1] = *(const f32x4*)(vp + i * 64 + 4); }
#pragma unroll
        for (int i = 0; i < NKS; ++i) kr[i] = pack8(ta[i][0], ta[i][1]);
#pragma unroll
        for (int i = 0; i < NVS; ++i) vr[i] = pack8(tb[i][0], tb[i][1]);
    } else {
        const bf16_t* kp = (const bf16_t*)s.k + (size_t)key * s.pitch + ch * 8;
        const bf16_t* vp = (const bf16_t*)s.v + (size_t)key * s.pitch + ch * 8;
#pragma unroll
        for (int i = 0; i < NKS; ++i) kr[i] = ok ? *(const u32x4*)(kp + i * 64) : z;
#pragma unroll
        for (int i = 0; i < NVS; ++i) vr[i] = ok ? *(const u32x4*)(vp + i * 64) : z;
    }
}
template <int NKS, int NVS> __device__ __forceinline__ void tile_store(LAS char* buf, const u32x4 (&kr)[NKS], const u32x4 (&vr)[NVS], int key, int ch) {
#pragma unroll
    for (int i = 0; i < NKS; ++i) *(LAS u32x4*)(buf + i * KSUB + key * 144 + ch * 16) = kr[i];
#pragma unroll
    for (int i = 0; i < NVS; ++i) *(LAS u32x4*)(buf + NKS * KSUB + i * VSUB + ((key >> 3) * 2 + (ch >> 2)) * 512 + (key & 7) * 64 + (ch & 3) * 16) = vr[i];
}
__device__ __forceinline__ void qk(f32x16 (&p)[2], const LAS char* ksub, const bf16x8 (&qf)[4], int kbase, float cinit) {
#pragma unroll
    for (int kb = 0; kb < 2; ++kb) {
        f32x16 c;
#pragma unroll
        for (int r = 0; r < 16; ++r) c[r] = cinit;
#pragma unroll
        for (int d0 = 0; d0 < 4; ++d0) { const bf16x8 kf = *(const LAS bf16x8*)(ksub + kbase + kb * 4608 + d0 * 32); c = __builtin_amdgcn_mfma_f32_32x32x16_bf16(kf, qf[d0], c, 0, 0, 0); }
        p[kb] = c;
    }
}
template <int NDB> __device__ __forceinline__ void pv(f32x16 (&o)[NDB], const LAS char* v0, const f32x16 (&p)[2], int vbase) {
#pragma unroll
    for (int kb = 0; kb < 2; ++kb)
#pragma unroll
        for (int jj = 0; jj < 2; ++jj) {
            u32x4 w; w.x = cvtpk(p[kb][8 * jj + 0], p[kb][8 * jj + 1]); w.y = cvtpk(p[kb][8 * jj + 2], p[kb][8 * jj + 3]); w.z = cvtpk(p[kb][8 * jj + 4], p[kb][8 * jj + 5]); w.w = cvtpk(p[kb][8 * jj + 6], p[kb][8 * jj + 7]);
            const bf16x8 pf = __builtin_bit_cast(bf16x8, w);
#pragma unroll
            for (int db = 0; db < NDB; ++db) {
                const LAS char* a = v0 + (db >> 1) * VSUB + vbase + kb * 4096 + jj * 1024 + (db & 1) * 512;
                const s16x4 lo = vtr(a), hi = vtr(a + 256);
                const bf16x8 vf = {lo[0], lo[1], lo[2], lo[3], hi[0], hi[1], hi[2], hi[3]};
                o[db] = __builtin_amdgcn_mfma_f32_32x32x16_bf16(vf, pf, o[db], 0, 0, 0);
            }
        }
}

__device__ __forceinline__ float fmin_s(float a, float b) { float r; asm("v_min_f32_e32 %0, %1, %2" : "=v"(r) : "v"(a), "v"(b)); return r; }
__device__ __forceinline__ float fmul_s(float a, float b) { float r; asm("v_mul_f32_e32 %0, %1, %2" : "=v"(r) : "v"(a), "v"(b)); return r; }
__device__ __forceinline__ float fsub_s(float a, float b) { float r; asm("v_sub_f32_e32 %0, %1, %2" : "=v"(r) : "v"(a), "v"(b)); return r; }
template <bool MASK> __device__ __forceinline__ void sb_weights(f32x16 (&p)[2], int lim, int hi, float& carry) {
    float T[2];
#pragma unroll
    for (int kb = 1; kb >= 0; --kb) {
        float run = 1.0f;
#pragma unroll
        for (int r = 15; r >= 0; --r) {
            float kp = __builtin_amdgcn_rcpf(1.0f + __builtin_amdgcn_exp2f(p[kb][r]));
            if (MASK) kp = (32 * kb + 16 * hi + r < lim) ? kp : 1.0f;
            const float nx = fmul_s(run, kp);
            p[kb][r] = fsub_s(run, nx);
            run = nx;
        }
        T[kb] = run;
    }
    float TA, TC; const float TB = swap_lo(T[1], TA), TD = swap_lo(T[0], TC);
    const float cA = carry * TA, cAB = cA * TB, cABC = cAB * TC;
    const float base1 = hi ? carry : cA, base0 = hi ? cAB : cABC;
    carry = cABC * TD;
#pragma unroll
    for (int r = 0; r < 16; ++r) { p[1][r] *= base1; p[0][r] *= base0; }
}
template <bool MASK> __device__ __forceinline__ void sm_weights(f32x16 (&p)[2], int lim, int hi, float& lsum) {
    float s = 0.f;
#pragma unroll
    for (int kb = 0; kb < 2; ++kb)
#pragma unroll
        for (int r = 0; r < 16; ++r) {
            float e = __builtin_amdgcn_exp2f(fmin_s(p[kb][r], 100.0f));
            if (MASK) e = (32 * kb + 16 * hi + r < lim) ? e : 0.0f;
            p[kb][r] = e; s += e;
        }
    lsum += s;
}

template <bool MASK> __device__ __forceinline__ void exp_stage(f32x16 (&p)[2], int lim, int hi) {
#pragma unroll
    for (int kb = 0; kb < 2; ++kb)
#pragma unroll
        for (int r = 0; r < 16; ++r) {
            float e = __builtin_amdgcn_exp2f(fmin_s(p[kb][r], 100.0f));
            if (MASK) e = (32 * kb + 16 * hi + r < lim) ? e : 0.0f;
            p[kb][r] = e;
        }
}
__device__ __forceinline__ void pack_stage(const f32x16 (&e)[2], bf16x8 (&pf)[4], float& lsum) {
    float s0 = 0.f, s1 = 0.f;
#pragma unroll
    for (int r = 0; r < 16; ++r) { s0 += e[0][r]; s1 += e[1][r]; }
    lsum += s0 + s1;
#pragma unroll
    for (int kb = 0; kb < 2; ++kb)
#pragma unroll
        for (int jj = 0; jj < 2; ++jj) {
            u32x4 w; w.x = cvtpk(e[kb][8 * jj + 0], e[kb][8 * jj + 1]); w.y = cvtpk(e[kb][8 * jj + 2], e[kb][8 * jj + 3]); w.z = cvtpk(e[kb][8 * jj + 4], e[kb][8 * jj + 5]); w.w = cvtpk(e[kb][8 * jj + 6], e[kb][8 * jj + 7]);
            typedef unsigned short us8_t __attribute__((ext_vector_type(8)));
            const us8_t lim8 = {0x7180, 0x7180, 0x7180, 0x7180, 0x7180, 0x7180, 0x7180, 0x7180};
            pf[kb * 2 + jj] = __builtin_bit_cast(bf16x8, __builtin_elementwise_min(__builtin_bit_cast(us8_t, w), lim8));
        }
}
template <int NDB> __device__ __forceinline__ void pv_packed(f32x16 (&o)[NDB], const LAS char* v0, const bf16x8 (&pf)[4], int vbase) {
#pragma unroll
    for (int kb = 0; kb < 2; ++kb)
#pragma unroll
        for (int jj = 0; jj < 2; ++jj)
#pragma unroll
            for (int db = 0; db < NDB; ++db) {
                const LAS char* a = v0 + (db >> 1) * VSUB + vbase + kb * 4096 + jj * 1024 + (db & 1) * 512;
                const s16x4 lo = vtr(a), hi = vtr(a + 256);
                const bf16x8 vf = {lo[0], lo[1], lo[2], lo[3], hi[0], hi[1], hi[2], hi[3]};
                o[db] = __builtin_amdgcn_mfma_f32_32x32x16_bf16(vf, pf[kb * 2 + jj], o[db], 0, 0, 0);
            }
}
template <int NDB> __device__ __forceinline__ void pipe_step(f32x16 (&o)[NDB], bf16x8 (&pf)[4], s16x4 (&vq)[8][2], float& lsum, const LAS char* kslot, const LAS char* vprev, const LAS char* vcur, const bf16x8 (&qf)[4], int kbase, int vbase) {
    static_assert(NDB == 4, "DIFF geometry");
#define DIFF_VFRAG(slot_, vs_, m_) do { const LAS char* a_ = (vs_) + (((m_) & 3) >> 1) * VSUB + vbase + ((m_) >> 3) * 4096 + (((m_) >> 2) & 1) * 1024 + ((m_) & 1) * 512; vq[slot_][0] = vtr(a_); vq[slot_][1] = vtr(a_ + 256); } while (0)
#define DIFF_PVMFMA(slot_, m_) do { const s16x4 lo_ = vq[slot_][0], hh_ = vq[slot_][1]; const bf16x8 vf_ = {lo_[0], lo_[1], lo_[2], lo_[3], hh_[0], hh_[1], hh_[2], hh_[3]}; \
        o[(m_) & 3] = __builtin_amdgcn_mfma_f32_32x32x16_bf16(vf_, pf[(m_) >> 2], o[(m_) & 3], 0, 0, 0); } while (0)
    bf16x8 kf[8];
#pragma unroll
    for (int i = 0; i < 8; ++i) kf[i] = *(const LAS bf16x8*)(kslot + kbase + (i >> 2) * 4608 + (i & 3) * 32);
    __builtin_amdgcn_sched_barrier(0);
#pragma unroll
    for (int m = 0; m < 8; ++m) { DIFF_PVMFMA(m, m); if (m < 4) DIFF_VFRAG(m, vprev, m + 8); __builtin_amdgcn_sched_barrier(0); }
    f32x16 e[2];
    {
        f32x16 c0, c1;
#pragma unroll
        for (int r = 0; r < 16; ++r) { c0[r] = 0.f; c1[r] = 0.f; }
#pragma unroll
        for (int d0 = 0; d0 < 4; ++d0) c0 = __builtin_amdgcn_mfma_f32_32x32x16_bf16(kf[d0], qf[d0], c0, 0, 0, 0);
        __builtin_amdgcn_sched_barrier(0);
#pragma unroll
        for (int d0 = 0; d0 < 4; ++d0) {
            c1 = __builtin_amdgcn_mfma_f32_32x32x16_bf16(kf[4 + d0], qf[d0], c1, 0, 0, 0);
            DIFF_VFRAG(4 + d0, vprev, 12 + d0);
#pragma unroll
            for (int r = 4 * d0; r < 4 * d0 + 4; ++r) c0[r] = __builtin_amdgcn_exp2f(c0[r]);
            __builtin_amdgcn_sched_barrier(0);
        }
        e[0] = c0; e[1] = c1;
    }
#pragma unroll
    for (int m = 8; m < 16; ++m) {
        DIFF_PVMFMA(m - 8, m); DIFF_VFRAG(m - 8, vcur, m - 8);
#pragma unroll
        for (int r = 2 * (m - 8); r < 2 * (m - 8) + 2; ++r) e[1][r] = __builtin_amdgcn_exp2f(e[1][r]);
        __builtin_amdgcn_sched_barrier(0);
    }
    pack_stage(e, pf, lsum);
    __builtin_amdgcn_sched_barrier(0);
}

template <int MODE, bool SMP = false> __device__ __forceinline__ void attn_unit(LAS char* lds, const Params& P, bool sample, int b, int hsel, int usel, const int wave_id) {
    constexpr int NKS = Geo<MODE>::NKS, NVS = Geo<MODE>::NVS, NDB = Geo<MODE>::NDB, BUFB = NKS * KSUB + NVS * VSUB;
    int tid_ = wave_id * 64 + lane_id_volatile(); asm volatile("" : "+v"(tid_));
    const int tid = tid_, lane = tid & 63, r32 = lane & 31, hi = lane >> 5;
    const int wave = wave_id;
    const int key = tid >> 3, ch = tid & 7;
    int qbw, ksub, vsub0;
    if (MODE == SB) { qbw = wave; ksub = 0; vsub0 = 0; }
    else if (MODE == DIFF) { qbw = wave & 3; ksub = wave >> 2; vsub0 = 0; }
    else { qbw = wave & 1; ksub = wave >> 1; vsub0 = wave >> 1; }
    int qrow0, nq, qpos0, qcol, kcol0, vcol0, ocol, t_lo, t_hi, npast, pastpos0, newpos0, newrow0, ppitch;
    const float* pk = nullptr; const float* pvp = nullptr;
    if (MODE == SB) {
        qcol = hsel * 64; kcol0 = 512 + hsel * 64; vcol0 = 1024 + hsel * 64; ocol = hsel * 64; ppitch = 512;
        if (!sample) { qrow0 = b * SEQ + usel * 256; nq = 256; qpos0 = usel * 256; t_lo = 0; t_hi = usel * 4 + 3; npast = 0; pastpos0 = 0; newpos0 = 0; newrow0 = b * SEQ; }
        else { qrow0 = MP + b * 32; nq = 32; qpos0 = 1024; t_lo = 0; t_hi = 16; npast = 16; pastpos0 = 0; newpos0 = 1024; newrow0 = MP + b * 32; pk = P.cK + (size_t)b * 1024 * 512 + hsel * 64; pvp = P.cV + (size_t)b * 1024 * 512 + hsel * 64; }
    } else if (MODE == DIFF) {
        qcol = 1536 + (hsel * 2 + ksub) * 64; kcol0 = 2048 + hsel * 128; vcol0 = 2560 + hsel * 128; ocol = 512 + hsel * 128; ppitch = 512;
        if (!sample) { qrow0 = b * SEQ + usel * 128; nq = 128; qpos0 = usel * 128; t_lo = 0; t_hi = usel * 2 + 1; npast = 0; pastpos0 = 0; newpos0 = 0; newrow0 = b * SEQ; }
        else { qrow0 = MP + b * 32; nq = 32; qpos0 = 1024; t_lo = 0; t_hi = 16; npast = 16; pastpos0 = 0; newpos0 = 1024; newrow0 = MP + b * 32; pk = P.cK + (size_t)b * 1024 * 512 + hsel * 128; pvp = P.cV + (size_t)b * 1024 * 512 + hsel * 128; }
    } else {
        qcol = (hsel * 4 + ksub) * 64; kcol0 = 1024 + hsel * 256; vcol0 = 2048 + hsel * 256; ocol = (hsel * 4 + ksub) * 64; ppitch = 1024;
        if (!sample) { qrow0 = b * SEQ + usel * 64; nq = 64; qpos0 = usel * 64; t_lo = usel > 8 ? usel - 8 : 0; t_hi = usel; npast = 0; pastpos0 = 0; newpos0 = 0; newrow0 = b * SEQ; }
        else { qrow0 = MP + b * 32; nq = 32; qpos0 = 1024; t_lo = 0; t_hi = 8; npast = 8; pastpos0 = 512; newpos0 = 1024; newrow0 = MP + b * 32; pk = P.cK + (size_t)b * 512 * 1024 + hsel * 256; pvp = P.cV + (size_t)b * 512 * 1024 + hsel * 256; }
    }
    const bool active = 32 * qbw < nq;
    const int nvnew = sample ? 32 : 64;
#define ATT_SRC(s_, tt_) do { const int _t = (tt_); \
        if (_t < npast) { (s_).k = pk + (size_t)_t * 64 * ppitch; (s_).v = pvp + (size_t)_t * 64 * ppitch; (s_).pitch = ppitch; (s_).f32 = 1; (s_).nvalid = 64; } \
        else { const size_t ro_ = (size_t)(newrow0 + (_t - npast) * 64) * NQKV; (s_).k = P.qkv + ro_ + kcol0; (s_).v = P.qkv + ro_ + vcol0; (s_).pitch = NQKV; (s_).f32 = 0; (s_).nvalid = nvnew; } } while (0)
    const int kbase = kpi(r32) * 144 + hi * 16;
    const int g = lane >> 4;
    const int vbase = hi * 2048 + ((lane >> 2) & 3) * 64 + (g & 1) * 32 + (lane & 3) * 8;
    const int qpos = qpos0 + 32 * qbw + r32;
    bf16x8 qf[4];
    {
        const bf16_t* qp = P.qkv + (size_t)(qrow0 + (active ? 32 * qbw : 0) + r32) * NQKV + qcol + hi * 8;
#pragma unroll
        for (int d0 = 0; d0 < 4; ++d0) qf[d0] = *(const bf16x8*)(qp + d0 * 16);
    }
    LAS float* btab = (LAS float*)(lds + ATT_BIAS_OFF);
    if (MODE == BAND) {
        for (int i = tid; i < 4 * 257; i += NTHREADS) btab[i] = P.bias[(size_t)(hsel * 4) * 257 + i] * LOG2E;
    }
    f32x16 o[NDB];
#pragma unroll
    for (int db = 0; db < NDB; ++db)
#pragma unroll
        for (int r = 0; r < 16; ++r) o[db][r] = 0.f;
    float carry = 1.0f;
    float lsum = 0.f;
#define ATT_COMPUTE() \
        const LAS char* kb_ = lds + buf * BUFB; \
 \
        const int kpos0 = (tt < npast) ? pastpos0 + 64 * tt : newpos0 + 64 * (tt - npast); \
        const int nval = (tt < npast) ? 64 : nvnew; \
        int lim; \
        if (MODE == SB) lim = qpos - kpos0; \
        else if (MODE == DIFF) lim = (qpos | 63) + 1 - kpos0; \
        else lim = 64; \
        lim = lim < nval ? lim : nval; \
        const bool any_vis = __any(lim > 0), need_mask = __any(lim < 64); \
        if (active && any_vis) { \
            f32x16 p[2]; \
            { \
                const int dbase = qpos0 + 32 * qbw - kpos0; \
                const LAS float* bt = btab + ksub * 257; \
                const bool flat = (MODE != BAND) || (dbase - 63 >= 128); \
                float cinit = 0.f; \
                if (MODE == BAND) { if (flat) cinit = bt[256]; } \
                qk(p, kb_ + ksub * KSUB, qf, kbase, cinit); \
                if (MODE == BAND) { \
                    if (!flat) { \
_Pragma("unroll") \
                        for (int kb = 0; kb < 2; ++kb) { \
                            const int d0_ = dbase + r32 - 32 * kb - 16 * hi + 128; \
_Pragma("unroll") \
                            for (int r = 0; r < 16; ++r) { int idx = d0_ - r; idx = idx < 0 ? 0 : (idx > 256 ? 256 : idx); p[kb][r] += bt[idx]; } \
                        } \
                    } \
                } \
            } \
            if (MODE == SB) { if (need_mask) sb_weights<true>(p, lim, hi, carry); else sb_weights<false>(p, lim, hi, carry); } \
            else { if (need_mask) sm_weights<true>(p, lim, hi, lsum); else sm_weights<false>(p, lim, hi, lsum); } \
            pv<NDB>(o, kb_ + NKS * KSUB + vsub0 * VSUB, p, vbase); \
        }
    int buf = 0;
    bool fast_done = false;
    if constexpr (MODE == DIFF) {
      if (!sample) {
        u32x4 kr[2][NKS], vr[2][NVS];
        const int ntile = t_hi + 1;
        const unsigned toff = (unsigned)(((newrow0 + key) * NQKV + kcol0 + ch * 8) * 2);
        static_assert((size_t)MT * NQKV * 2 < (1ull << 32), "32-bit offsets");
#define DIFF_LOAD(set_, t_) do { const int tq_ = (t_); const char* tb_ = (const char*)P.qkv + (size_t)(tq_ > 0 ? tq_ : 0) * (64 * NQKV * 2); \
            kr[set_][0] = *(const u32x4*)(tb_ + toff); kr[set_][1] = *(const u32x4*)(tb_ + toff + 128); vr[set_][0] = *(const u32x4*)(tb_ + toff + 1024); vr[set_][1] = *(const u32x4*)(tb_ + toff + 1152); } while (0)
        DIFF_LOAD(0, t_hi); tile_store<NKS, NVS>(lds, kr[0], vr[0], key, ch);
        DIFF_LOAD(1, t_hi - 1); DIFF_LOAD(0, t_hi - 2);
        __syncthreads();
        f32x16 e[2];
        { int lim = (qpos | 63) + 1 - 64 * t_hi; lim = lim < 64 ? lim : 64;
          qk(e, lds + ksub * KSUB, qf, kbase, 0.f); if (__any(lim < 64)) exp_stage<true>(e, lim, hi); else exp_stage<false>(e, lim, hi); }
        bf16x8 pf[4]; pack_stage(e, pf, lsum);
        s16x4 vq[8][2];
#pragma unroll
        for (int m = 0; m < 8; ++m) DIFF_VFRAG(m, lds + NKS * KSUB, m);
        tile_store<NKS, NVS>(lds + BUFB, kr[1], vr[1], key, ch);
        DIFF_LOAD(1, t_hi - 3);
        __syncthreads();
        int sj = 1, sp = 0;
        int j = 1;
        for (; j + 1 < ntile; j += 2) {
            pipe_step<NDB>(o, pf, vq, lsum, lds + sj * BUFB + ksub * KSUB, lds + sp * BUFB + NKS * KSUB, lds + sj * BUFB + NKS * KSUB, qf, kbase, vbase);
            int sn = (sj == 2) ? 0 : sj + 1;
            tile_store<NKS, NVS>(lds + sn * BUFB, kr[0], vr[0], key, ch);
            DIFF_LOAD(0, t_hi - j - 3);
            __syncthreads();
            sp = sj; sj = sn;
            pipe_step<NDB>(o, pf, vq, lsum, lds + sj * BUFB + ksub * KSUB, lds + sp * BUFB + NKS * KSUB, lds + sj * BUFB + NKS * KSUB, qf, kbase, vbase);
            sn = (sj == 2) ? 0 : sj + 1;
            tile_store<NKS, NVS>(lds + sn * BUFB, kr[1], vr[1], key, ch);
            DIFF_LOAD(1, t_hi - j - 4);
            __syncthreads();
            sp = sj; sj = sn;
        }
        if (j < ntile) {
            pipe_step<NDB>(o, pf, vq, lsum, lds + sj * BUFB + ksub * KSUB, lds + sp * BUFB + NKS * KSUB, lds + sj * BUFB + NKS * KSUB, qf, kbase, vbase);
            __syncthreads();
            sp = sj;
        }
        pv_packed<NDB>(o, lds + sp * BUFB + NKS * KSUB, pf, vbase);
        __syncthreads();
#undef DIFF_LOAD
#undef DIFF_VFRAG
#undef DIFF_PVMFMA
        fast_done = true;
      }
    }
    if (!fast_done) {
        LAS int* dflag = (LAS int*)(lds + ATT_BIAS_OFF);
        u32x4 kr[NKS], vr[NVS];
        { TileSrc s0; ATT_SRC(s0, t_hi); tile_load<NKS, NVS>(kr, vr, s0, key, ch); tile_store<NKS, NVS>(lds, kr, vr, key, ch); }
        __syncthreads();
        bool stop = false;
        for (int tt = t_hi; tt >= t_lo && !stop; --tt) {
            const bool more = tt > t_lo;
            f32x4 ta[SMP ? NKS : 1][2], tb[SMP ? NVS : 1][2]; bool raw32 = false;
            if (more) { TileSrc s1; ATT_SRC(s1, tt - 1);
                if constexpr (SMP) { raw32 = s1.f32 != 0;
                    if (raw32) { const float* kp = (const float*)s1.k + (size_t)key * s1.pitch + ch * 8; const float* vp = (const float*)s1.v + (size_t)key * s1.pitch + ch * 8;
#pragma unroll
                        for (int i = 0; i < NKS; ++i) { ta[i][0] = *(const f32x4*)(kp + i * 64); ta[i][1] = *(const f32x4*)(kp + i * 64 + 4); }
#pragma unroll
                        for (int i = 0; i < NVS; ++i) { tb[i][0] = *(const f32x4*)(vp + i * 64); tb[i][1] = *(const f32x4*)(vp + i * 64 + 4); } }
                    else tile_load<NKS, NVS>(kr, vr, s1, key, ch);
                } else tile_load<NKS, NVS>(kr, vr, s1, key, ch); }
            ATT_COMPUTE()
            if (MODE == SB) { const bool wdead = !active || __all(carry < 1e-30f); if (lane == 0) dflag[buf * 8 + wave] = wdead ? 1 : 0; }
            if constexpr (SMP) { if (more && raw32) {
#pragma unroll
                for (int i = 0; i < NKS; ++i) kr[i] = pack8(ta[i][0], ta[i][1]);
#pragma unroll
                for (int i = 0; i < NVS; ++i) vr[i] = pack8(tb[i][0], tb[i][1]); } }
            if (more) tile_store<NKS, NVS>(lds + (buf ^ 1) * BUFB, kr, vr, key, ch);
            __syncthreads();
            if (MODE == SB) { int a = 1;
#pragma unroll
                for (int w = 0; w < 8; ++w) a &= dflag[buf * 8 + w];
                stop = a != 0; }
            buf ^= 1;
        }
    }
#undef ATT_COMPUTE
    int r32e = lane_id_volatile() & 31;
    bf16_t* orow = P.o + (size_t)(qrow0 + 32 * qbw + r32e) * D + ocol;
    if (MODE == SB) {
        if (active) {
#pragma unroll
            for (int db = 0; db < NDB; ++db)
#pragma unroll
                for (int rg = 0; rg < 4; ++rg) { u32x2 w; w.x = cvtpk(o[db][4 * rg], o[db][4 * rg + 1]); w.y = cvtpk(o[db][4 * rg + 2], o[db][4 * rg + 3]); st8(orow + 32 * db + 8 * rg + 4 * hi, w, sample); }
        }
    } else if (MODE == BAND) {
        float lh; const float ll = swap_lo(lsum, lh); const float inv = 1.0f / (ll + lh);
        if (active) {
#pragma unroll
            for (int db = 0; db < NDB; ++db)
#pragma unroll
                for (int rg = 0; rg < 4; ++rg) { u32x2 w; w.x = cvtpk(o[db][4 * rg] * inv, o[db][4 * rg + 1] * inv); w.y = cvtpk(o[db][4 * rg + 2] * inv, o[db][4 * rg + 3] * inv); st8(orow + 32 * db + 8 * rg + 4 * hi, w, sample); }
        }
    } else {
        float lh; const float ll = swap_lo(lsum, lh); const float inv = 1.0f / (ll + lh);
        LAS float* xch = (LAS float*)lds + (size_t)qbw * 128 * 32;
        if (active && ksub == 1) {
            const float* lp_ = P.lamp; asm volatile("" : "+s"(lp_));
            const float f = lp_[0] * inv;
#pragma unroll
            for (int db = 0; db < NDB; ++db)
#pragma unroll
                for (int r = 0; r < 16; ++r) xch[(32 * db + 8 * (r >> 2) + 4 * hi + (r & 3)) * 32 + r32] = o[db][r] * f;
        }
        __syncthreads();
        if (active && ksub == 0) {
            float ssq = 0.f;
#pragma unroll
            for (int db = 0; db < NDB; ++db)
#pragma unroll
                for (int r = 0; r < 16; ++r) { const float a = o[db][r] * inv - xch[(32 * db + 8 * (r >> 2) + 4 * hi + (r & 3)) * 32 + r32]; o[db][r] = a; ssq += a * a; }
            float sh; const float sl = swap_lo(ssq, sh);
            const float* lp_ = P.lamp; asm volatile("" : "+s"(lp_));
            const float rn = rsqrtf((sl + sh) * (1.0f / 128.0f) + EPS) * (1.0f - lp_[1]);
            const float* gp = P.gain + hsel * 128;
#pragma unroll
            for (int db = 0; db < NDB; ++db)
#pragma unroll
                for (int rg = 0; rg < 4; ++rg) {
                    const int d = 32 * db + 8 * rg + 4 * hi;
                    const f32x4 gv = *(const f32x4*)(gp + d);
                    u32x2 w; w.x = cvtpk(o[db][4 * rg] * rn * gv[0], o[db][4 * rg + 1] * rn * gv[1]); w.y = cvtpk(o[db][4 * rg + 2] * rn * gv[2], o[db][4 * rg + 3] * rn * gv[3]);
                    st8(orow + d, w, sample);
                }
        }
    }
    __syncthreads();
#undef ATT_SRC
}
}
typedef GAS unsigned gu32;
#define XB_TMO      128
#define XB_XCNT(j)  (256  + 64 * (j))
#define XB_XSUB(j)  (1280 + 64 * (j))
#define XB_XGEN(j)  (2304 + 64 * (j))
#define XB_TOP      3328
#define XB_TOPGEN   3392
#define XCD_BAR_WORDS 3456
#define XB_SPIN_CAP (1u << 18)

__device__ __forceinline__ unsigned xb_ld(unsigned* p)              { return __hip_atomic_load(p, __ATOMIC_RELAXED, __HIP_MEMORY_SCOPE_AGENT); }
__device__ __forceinline__ unsigned xb_add(unsigned* p, unsigned v) { return __hip_atomic_fetch_add(p, v, __ATOMIC_RELAXED, __HIP_MEMORY_SCOPE_AGENT); }
__device__ __forceinline__ unsigned xb_xcc_id() { return (unsigned)__builtin_amdgcn_s_getreg((3 << 11) | 20) & 0xFu; }
#define XB_SPIN(cond, bar) do { unsigned _sp = 0; while (cond) { __builtin_amdgcn_s_sleep(1); \
    if ((++_sp & 255u) == 0u) { if (xb_ld(&(bar)[XB_TMO])) break; if (_sp > XB_SPIN_CAP) { atomicAdd(&(bar)[XB_TMO], 1u); break; } } } } while (0)

struct XcdBarrier {
    unsigned* bar; unsigned x;
    volatile LAS unsigned* st;
};

__device__ __forceinline__ XcdBarrier xcd_barrier_post(unsigned* bar, volatile LAS unsigned* st) {
    XcdBarrier b; b.bar = bar; b.x = xb_xcc_id(); b.st = st;
    if (threadIdx.x == 0) (void)xb_add(&bar[XB_XCNT(b.x)], 1u);
    return b;
}
__device__ __forceinline__ void xcd_barrier_complete(unsigned* bar, unsigned x, unsigned& nloc, unsigned& nx) {
    const unsigned G = gridDim.x * gridDim.y * gridDim.z;
    unsigned sum, cnt, mine, sp = 0u;
    for (;;) {
        sum = 0u; cnt = 0u; mine = 0u;
#pragma unroll
        for (unsigned j = 0; j < 16; ++j) { const unsigned c = xb_ld(&bar[XB_XCNT(j)]); sum += c; cnt += (c > 0u) ? 1u : 0u; mine = (j == x) ? c : mine; }
        if (sum == G) break;
        __builtin_amdgcn_s_sleep(1);
        if ((++sp & 255u) == 0u) { if (xb_ld(&bar[XB_TMO])) break; if (sp > XB_SPIN_CAP) { atomicAdd(&bar[XB_TMO], 1u); break; } }
    }
    nloc = mine > 0u ? mine : 1u; nx = cnt > 0u ? cnt : 1u;
}

__device__ __forceinline__ void xcd_barrier(const XcdBarrier& b) {
    asm volatile("s_waitcnt vmcnt(0)" ::: "memory");
    __syncthreads();
    if (threadIdx.x == 0) {
        unsigned* bar = b.bar;
        __builtin_amdgcn_s_waitcnt(0);
        unsigned nloc = b.st[0], nx = b.st[1];
        if (nloc == 0u) { xcd_barrier_complete(bar, b.x, nloc, nx); b.st[0] = nloc; b.st[1] = nx; }
        const unsigned old = xb_add(&bar[XB_XSUB(b.x)], 1u);
        const unsigned gen = old / nloc;
        if (old + 1u == (gen + 1u) * nloc) {
            __builtin_amdgcn_fence(__ATOMIC_RELEASE, "agent");
            asm volatile("s_waitcnt vmcnt(0)" ::: "memory");
            const unsigned og = xb_add(&bar[XB_TOP], 1u);
            const unsigned tg = og / nx;
            if (og + 1u == (tg + 1u) * nx) xb_add(&bar[XB_TOPGEN], 1u);
            else XB_SPIN(xb_ld(&bar[XB_TOPGEN]) == tg, bar);
            __builtin_amdgcn_fence(__ATOMIC_ACQUIRE, "agent");
            xb_add(&bar[XB_XGEN(b.x)], 1u);
            asm volatile("s_waitcnt vmcnt(0)" ::: "memory");
        } else {
            XB_SPIN(xb_ld(&bar[XB_XGEN(b.x)]) == gen, bar);
            __builtin_amdgcn_fence(__ATOMIC_ACQUIRE, "agent");
            asm volatile("s_waitcnt vmcnt(0)" ::: "memory");
        }
    }
    __syncthreads();
}

#ifndef CHAIN
#define CHAIN 1
#endif
#ifndef SAMPLE_SMALL
#define SAMPLE_SMALL 0
#endif
#ifndef QKV_REP
#define QKV_REP 1
#endif
#ifndef GU_REP
#define GU_REP 1
#endif
#ifndef ATT_REP_EVEN
#define ATT_REP_EVEN 1
#endif
#ifndef ATT_REP_ODD
#define ATT_REP_ODD 1
#endif
#ifndef EN_P0
#define EN_P0 1
#endif
#ifndef EN_QKV
#define EN_QKV 1
#endif
#ifndef EN_ATT
#define EN_ATT 1
#endif
#ifndef EN_OUT
#define EN_OUT 1
#endif
#ifndef EN_GU
#define EN_GU 1
#endif
#ifndef EN_DN
#define EN_DN 1
#endif
#ifndef EN_PLE
#define EN_PLE 1
#endif
__device__ __forceinline__ int dest_row(int map, int c) {
    if (map == 1) { if (c >= 1536 && c < 2560) { const int l = c & 63, half = l >> 5, i = l & 31; return (c & ~63) + 32 * (i >> 4) + 8 * ((i >> 2) & 3) + 4 * half + (i & 3); } return c; }
    if (map == 2) return 8 * (c >> 2) + (c & 3);
    if (map == 3) return 8 * (c >> 2) + 4 + (c & 3);
    return c;
}
__device__ __forceinline__ void transpose_item(const float* W, int K, int N, bf16_t* WT, const float* gain, int map, LAS float* scr, int item, int lane) {
    const int nblk = N / 32, kb = item / nblk, nb = item % nblk, k0 = 64 * kb, n0 = 32 * nb;
    float wv[32];
#pragma unroll
    for (int i = 0; i < 32; ++i) wv[i] = W[(size_t)(k0 + 2 * i + (lane >> 5)) * N + n0 + (lane & 31)];
#pragma unroll
    for (int i = 0; i < 32; ++i) { const int kk = 2 * i + (lane >> 5); const float gk = gain ? gain[k0 + kk] : 1.0f; scr[kk * 33 + (lane & 31)] = wv[i] * gk; }
    LDS_WAIT(); asm volatile("" ::: "memory");
    const int c = lane & 7;
#pragma unroll
    for (int j = 0; j < 4; ++j) { const int n = (lane >> 3) + 8 * j; const LAS float* s = scr + (8 * c) * 33 + n;
        u32x4 o; o.x = cvtpk(s[0 * 33], s[1 * 33]); o.y = cvtpk(s[2 * 33], s[3 * 33]); o.z = cvtpk(s[4 * 33], s[5 * 33]); o.w = cvtpk(s[6 * 33], s[7 * 33]);
        *(u32x4*)(WT + (size_t)dest_row(map, n0 + n) * K + k0 + 8 * c) = o; }
    LDS_WAIT(); asm volatile("" ::: "memory");
}

__device__ __forceinline__ unsigned chain_kind(unsigned st) { const unsigned r = st % 12u; return (r == 0u || r == 6u) ? 0u : (r < 6u ? r : r - 6u); }
__device__ __forceinline__ unsigned chain_layer(unsigned st) { const unsigned r = st % 12u; return 2u * (st / 12u) + (r >= 6u ? 1u : 0u); }
__device__ __forceinline__ unsigned chain_n(unsigned st) { const unsigned k = chain_kind(st); return k == 0u ? 48u : k == 1u ? ((st % 12u) == 1u ? 384u : 128u) : k == 3u ? 88u : k == 4u ? 32u : 16u; }
constexpr int MROWS = (SAMPLE_SMALL || CHAIN) ? MP : MT;
struct Args { const float* in[26]; float* out; unsigned char* ws; };

__global__ void __launch_bounds__(NTHREADS, 2) trunk_fwd(Args args) {
    extern __shared__ __attribute__((aligned(16))) unsigned char lds_raw[];
    LAS unsigned char* lds = (LAS unsigned char*)lds_raw;
    volatile LAS unsigned* MISC = (volatile LAS unsigned*)(lds + LDSCTL_OFF);
    const int wave = __builtin_amdgcn_readfirstlane((int)threadIdx.x >> 6);
#define LANE_TID() const int lane = lane_id_volatile(); const int tid = wave * 64 + lane; (void)tid; (void)lane
    const int G = gridDim.x;
    typedef __attribute__((address_space(4))) const Args CArgs;
#define ARGS_HERE() CArgs* ap = (CArgs*)__builtin_amdgcn_kernarg_segment_ptr(); asm volatile("" : "+s"(ap)); unsigned char* ws = ap->ws; (void)ws
#define WSPTRS() ss_t* ssb = (ss_t*)(ws + WS_SS); float* hf = (float*)(ws + WS_H); bf16_t* hb = (bf16_t*)(ws + WS_HB); bf16_t* hb2 = (bf16_t*)(ws + WS_HB2); (void)hb2; bf16_t* qkv = (bf16_t*)(ws + WS_QKV); bf16_t* act = (bf16_t*)(ws + WS_ACT); \
    bf16_t* ob = (bf16_t*)(ws + WS_O); bf16_t* plb = (bf16_t*)(ws + WS_PL); bf16_t* pb = (bf16_t*)(ws + WS_PB); float* ropec = (float*)(ws + WS_ROPEC); float* ropes = (float*)(ws + WS_ROPES); float* lamv = (float*)(ws + WS_LAM); \
    (void)ssb; (void)hf; (void)hb; (void)qkv; (void)act; (void)ob; (void)plb; (void)pb; (void)ropec; (void)ropes; (void)lamv
    { LANE_TID(); for (int u = tid; u < (LDS_BYTES - LDSCTL_OFF) / 4; u += NTHREADS) MISC[u] = 0u; }
    __syncthreads();
    { LANE_TID(); if (tid == 0) (void)xb_add(&((unsigned*)(args.ws + WS_CTL) + CW_BAR)[XB_XCNT(xb_xcc_id())], 1u); }
#define GRID_BARRIER() do { CArgs* ap_ = (CArgs*)__builtin_amdgcn_kernarg_segment_ptr(); asm volatile("" : "+s"(ap_)); XcdBarrier b_; b_.bar = (unsigned*)(ap_->ws + WS_CTL) + CW_BAR; b_.x = xb_xcc_id(); b_.st = MISC + 8; xcd_barrier(b_); } while (0)

#if EN_P0
    {
        ARGS_HERE(); WSPTRS(); LANE_TID();
        const float* x_prompt = ap->in[0]; const float* x_sample = ap->in[1]; const float* p_prompt = ap->in[8]; const float* p_sample = ap->in[9];
        const float* norm_mix = ap->in[10]; const float* w_in_even = ap->in[11]; const float* w_out_even = ap->in[12]; const float* diff_lambda = ap->in[13];
        const float* w_in_odd = ap->in[15]; const float* w_out_odd = ap->in[16]; const float* norm_ffn = ap->in[18];
        const float* w_gate = ap->in[19]; const float* w_up = ap->in[20]; const float* w_down = ap->in[21]; const float* norm_ple = ap->in[22]; const float* w_ple_gate = ap->in[23]; const float* w_ple = ap->in[24];
        const int gw = blockIdx.x * NWAVES + wave, NGW = G * NWAVES;
        LAS float* scr = (LAS float*)(lds + wave * 16384);
        constexpr int I_IN = 16 * 96, I_OUT = 16 * 32, I_G = 16 * 88, I_DN = 44 * 32, I_PG = 16 * 32, I_PL = 4 * 32, I_LAYER = I_IN + I_OUT + 2 * I_G + I_DN + I_PG + I_PL;
        for (int it = gw; it < NLAYER * I_LAYER; it += NGW) {
            const int li = it / I_LAYER; int r = it % I_LAYER; const int eo = li >> 1;
            unsigned char* wl = ws + WS_W + (size_t)li * W_LAYER;
            if (r < I_IN) { const float* W = (li & 1) ? w_in_odd + (size_t)eo * D * NQKV : w_in_even + (size_t)eo * D * NQKV; transpose_item(W, D, NQKV, (bf16_t*)(wl + WO_IN), norm_mix + li * D, (li & 1) ? 0 : 1, scr, r, lane); continue; } r -= I_IN;
            if (r < I_OUT) { const float* W = (li & 1) ? w_out_odd + (size_t)eo * D * D : w_out_even + (size_t)eo * D * D; transpose_item(W, D, D, (bf16_t*)(wl + WO_OUT), nullptr, 0, scr, r, lane); continue; } r -= I_OUT;
            if (r < I_G) { transpose_item(w_gate + (size_t)li * D * FFN, D, FFN, (bf16_t*)(wl + WO_GU), norm_ffn + li * D, 2, scr, r, lane); continue; } r -= I_G;
            if (r < I_G) { transpose_item(w_up + (size_t)li * D * FFN, D, FFN, (bf16_t*)(wl + WO_GU), norm_ffn + li * D, 3, scr, r, lane); continue; } r -= I_G;
            if (r < I_DN) { transpose_item(w_down + (size_t)li * FFN * D, FFN, D, (bf16_t*)(wl + WO_DN), nullptr, 0, scr, r, lane); continue; } r -= I_DN;
            if (r < I_PG) { transpose_item(w_ple_gate + (size_t)li * D * D, D, D, (bf16_t*)(wl + WO_PG), norm_ple + li * D, 0, scr, r, lane); continue; } r -= I_PG;
            transpose_item(w_ple + (size_t)li * PLE * D, PLE, D, (bf16_t*)(wl + WO_PL), nullptr, 0, scr, r, lane);
        }
        for (int r0 = gw; r0 < MT; r0 += 2 * NGW) {
            f32x4 v[2][4];
#pragma unroll
            for (int q = 0; q < 2; ++q) { const int r = r0 + q * NGW; if (r < MT) { const float* xr = (r < MP) ? x_prompt + (size_t)r * D : x_sample + (size_t)(r - MP) * D;
#pragma unroll
                for (int j = 0; j < 4; ++j) v[q][j] = *(const f32x4*)(xr + 4 * lane + 256 * j); } }
#pragma unroll
            for (int q = 0; q < 2; ++q) { const int r = r0 + q * NGW; if (r < MT) { float s = 0.f;
#pragma unroll
                for (int j = 0; j < 4; ++j) { const f32x4 x4 = v[q][j]; s += (x4[0] * x4[0] + x4[1] * x4[1]) + (x4[2] * x4[2] + x4[3] * x4[3]);
                    u32x2 w; w.x = cvtpk(x4[0], x4[1]); w.y = cvtpk(x4[2], x4[3]); *(u32x2*)(hb2 + (size_t)r * D + 4 * lane + 256 * j) = w; }
                s = wave_sum(s);
                if (lane == 0) ssb[r] = (ss_t)__float2ull_rn(s * SS_SCALE); } }
        }
        for (int it0 = gw; it0 < NLAYER * MT; it0 += 8 * NGW) {
            f32x4 v[8];
#pragma unroll
            for (int q = 0; q < 8; ++q) { const int it = it0 + q * NGW; if (it < NLAYER * MT) { const int li = it / MT, r = it % MT;
                const float* pr = (r < MP) ? p_prompt + ((size_t)li * MP + r) * PLE : p_sample + ((size_t)li * MS + (r - MP)) * PLE; v[q] = *(const f32x4*)(pr + 4 * lane); } }
#pragma unroll
            for (int q = 0; q < 8; ++q) { const int it = it0 + q * NGW; if (it < NLAYER * MT) { u32x2 w; w.x = cvtpk(v[q][0], v[q][1]); w.y = cvtpk(v[q][2], v[q][3]); *(u32x2*)(pb + (size_t)it * PLE + 4 * lane) = w; } }
        }
        for (int idx = blockIdx.x * NTHREADS + tid; idx < SEQ * 32; idx += G * NTHREADS) {
            const int pos = idx >> 5, i = idx & 31;
            const float inv = exp2f(-(float)i * (13.287712379549449f / 32.0f));
            const float ang = (float)pos * inv;
            const double rev = (double)ang * 0.15915494309189535;
            const double fr = rev - rint(rev);
            const float a = (float)(fr * 6.283185307179586);
            ropec[idx] = cosf(a); ropes[idx] = sinf(a);
        }
        if (blockIdx.x == 0 && wave < 2) {
            const float* lp = diff_lambda + wave * 256;
            const float s1 = wave_sum(lp[lane] * lp[64 + lane]), s2 = wave_sum(lp[128 + lane] * lp[192 + lane]);
            const float li_ = 0.8f - 0.6f * expf(-0.3f * (float)(2 * wave));
            if (lane == 0) { lamv[2 * wave] = expf(s1) - expf(s2) + li_; lamv[2 * wave + 1] = li_; }
        }
    }
#endif
    GRID_BARRIER();

    for (int li = 0; li < NLAYER; ++li) {
        const int eo = li >> 1;
#define LAYER_PTRS() ARGS_HERE(); WSPTRS(); unsigned char* wl = ws + WS_W + (size_t)li * W_LAYER; float* out = ap->out; (void)out; (void)wl; \
        const ss_t* ss_mix = ssb + (size_t)(3 * li) * MT; ss_t* ss_ffn = ssb + (size_t)(3 * li + 1) * MT; ss_t* ss_ple = ssb + (size_t)(3 * li + 2) * MT; ss_t* ss_nxt = ssb + (size_t)(3 * li + 3) * MT; \
        (void)ss_mix; (void)ss_ffn; (void)ss_ple; (void)ss_nxt
#if EN_QKV
        for (int rep_ = 0; rep_ < QKV_REP; ++rep_) {
            if (rep_) GRID_BARRIER();
            LAYER_PTRS();
            const bf16_t* Bw = (const bf16_t*)(wl + WO_IN);
            pg8::Gemm g{hb2, Bw, MROWS, NQKV, D}; pg8::StaticOrder S; S.init(MROWS, NQKV, G, (int)blockIdx.x);
            if (li & 1) { BigEpi<RQkvOdd> E{{qkv, ss_mix, out, eo, nullptr, false}}; if (SAMPLE_SMALL) small_gemm(hb2, Bw, NQKV, D, E.e, wave, G); pg8::gemm_phase<BigEpi<RQkvOdd>, pg8::StaticOrder, true, true>(lds, g, S, E, wave); }
            else { BigEpi<RQkvEven> E{{qkv, ss_mix, ropec, ropes, out, eo, nullptr, false}}; if (SAMPLE_SMALL) small_gemm(hb2, Bw, NQKV, D, E.e, wave, G); pg8::gemm_phase<BigEpi<RQkvEven>, pg8::StaticOrder, true, true>(lds, g, S, E, wave); }
        }
#endif
        GRID_BARRIER();
#if EN_ATT
        {
            LAYER_PTRS();
            const float* cache_sb_k = ap->in[2]; const float* cache_sb_v = ap->in[3]; const float* cache_diff_k = ap->in[4]; const float* cache_diff_v = ap->in[5];
            const float* cache_band_k = ap->in[6]; const float* cache_band_v = ap->in[7]; const float* diff_norm = ap->in[14]; const float* rel_bias = ap->in[17]; const float* x_sample = ap->in[1];
            LANE_TID();
            for (int rep = 0; rep < ((li & 1) ? ATT_REP_ODD : ATT_REP_EVEN); ++rep) {
            if (rep) GRID_BARRIER();
            const bool even = !(li & 1);
            const unsigned NUQ = 256u;
            const unsigned NST = (rep == 0 && CHAIN) ? 24u : 0u;
            const unsigned SEND = NST ? 12u * (unsigned)(li >> 1) + ((li & 1) ? 12u : 7u) : 0u;
            unsigned* ctlw = (unsigned*)(ws + WS_CTL);
            unsigned* qbase = ctlw + CW_QUEUE + 64 * 8 * (li + 4 * rep);
            unsigned* chain = ctlw + CW_CHAIN;
#define CHAIN_N(st_) chain_n(st_)
            if (tid == 0) { MISC[19] = xb_xcc_id() & 7u; MISC[22] = 0u; MISC[23] = 0u; }
            __syncthreads();
            int npoll = 0;
            for (;;) {
                if (tid == 0) {
                    unsigned got = 0u, st = NST;
                    if (NST) {
                        st = atomicAdd(chain, 0u);
                        if (st < SEND) { const unsigned n = CHAIN_N(st);
                            if (MISC[23] != st + 1u) { const unsigned i = atomicAdd(chain + 64 * (1 + st), 1u);
                                if (i < n) { got = 1u; MISC[17] = st; MISC[18] = i; __builtin_amdgcn_fence(__ATOMIC_ACQUIRE, "agent"); } else MISC[23] = st + 1u; } }
                    }
                    unsigned ui = 0xffffffffu;
                    if (!got) { unsigned xq = MISC[19], tr = MISC[22];
                        while (tr < 8u) { const unsigned i = atomicAdd(qbase + 64 * xq, 1u); if (i < NUQ) { ui = i; break; } xq = (xq + 1u) & 7u; ++tr; }
                        MISC[19] = xq; MISC[22] = tr; }
                    MISC[16] = ui; MISC[20] = got; MISC[21] = st;
                    asm volatile("s_waitcnt vmcnt(0)" ::: "memory");
                }
                __syncthreads();
                const unsigned ui = __builtin_amdgcn_readfirstlane(MISC[16]), got = __builtin_amdgcn_readfirstlane(MISC[20]), stv = __builtin_amdgcn_readfirstlane(MISC[21]);
                const unsigned cst = __builtin_amdgcn_readfirstlane(MISC[17]), ci = __builtin_amdgcn_readfirstlane(MISC[18]), xq = __builtin_amdgcn_readfirstlane(MISC[19]);
                __syncthreads();
                int mode = -1, b = 0, hsel = 0, usel = 0, gkind = 0, gL = li, gitem = 0; bool sample = false;
                if (got) {
                    const unsigned s6 = chain_kind(cst); gL = (int)chain_layer(cst); sample = true;
                    if (s6 == 0u) { gkind = (gL & 1) ? 1 : 0; gitem = (int)ci; }
                    else if (s6 == 1u) { if (gL & 1) { mode = 2; b = (int)(ci >> 2); hsel = (int)(ci & 3u); }
                                         else if (ci < 256u) { mode = 0; b = (int)(ci >> 3); hsel = (int)(ci & 7u); }
                                         else { const unsigned j = ci - 256u; mode = 1; b = (int)(j >> 2); hsel = (int)(j & 3u); } }
                    else if (s6 == 2u) { gkind = 2; gitem = (int)ci; }
                    else if (s6 == 3u) { gkind = 3; gitem = (int)ci; }
                    else if (s6 == 4u) { if (ci < 16u) { gkind = 4; gitem = (int)ci; } else { gkind = 5; gitem = (int)ci - 16; } }
                    else { gkind = 6; gitem = (int)ci; }
                } else if (ui != 0xffffffffu) {
                    if (even) { if (ui < 128u) { const int p = (int)(xq + 8u * (ui >> 6)); mode = 1; b = p >> 2; hsel = p & 3; usel = 63 - (int)(ui & 63u); }
                                else { const unsigned j = ui - 128u; const int q = (int)(xq + 8u * (j >> 5)); mode = 0; b = q >> 3; hsel = q & 7; usel = 31 - (int)(j & 31u); } }
                    else { const int p = (int)(xq + 8u * (ui >> 7)); mode = 2; b = p >> 2; hsel = p & 3; usel = 127 - (int)(ui & 127u); }
                } else {
                    if (stv >= SEND) break;
                    __builtin_amdgcn_s_sleep(64); if (++npoll > (1 << 20)) break; continue;
                }
                const size_t eoL = (size_t)(gL >> 1);
                if (mode == 0) { const att::Params PS{qkv, ob, cache_sb_k + eoL * 32 * 1024 * 512, cache_sb_v + eoL * 32 * 1024 * 512, nullptr, nullptr, nullptr};
                    if (sample) att::attn_unit<att::SB, true>((LAS char*)lds, PS, sample, b, hsel, usel, wave); else att::attn_unit<att::SB>((LAS char*)lds, PS, sample, b, hsel, usel, wave); }
                else if (mode == 1) { const att::Params PD{qkv, ob, cache_diff_k + eoL * 32 * 1024 * 512, cache_diff_v + eoL * 32 * 1024 * 512, diff_norm + eoL * 512, nullptr, lamv + 2 * eoL};
                    if (sample) att::attn_unit<att::DIFF, true>((LAS char*)lds, PD, sample, b, hsel, usel, wave); else att::attn_unit<att::DIFF>((LAS char*)lds, PD, sample, b, hsel, usel, wave); }
                else if (mode == 2) { const att::Params PB{qkv, ob, cache_band_k + eoL * 32 * 512 * 1024, cache_band_v + eoL * 32 * 512 * 1024, nullptr, rel_bias + eoL * 16 * 257, nullptr};
                    if (sample) att::attn_unit<att::BAND, true>((LAS char*)lds, PB, sample, b, hsel, usel, wave); else att::attn_unit<att::BAND>((LAS char*)lds, PB, sample, b, hsel, usel, wave); }
                else {
                    unsigned char* wl2 = ws + WS_W + (size_t)gL * W_LAYER;
                    const bf16_t* A; const bf16_t* Bw; int N_, K_; ss_t* ssn2 = nullptr;
                    if (gkind <= 1) { A = hb2; Bw = (const bf16_t*)(wl2 + WO_IN); N_ = NQKV; K_ = D; }
                    else if (gkind == 2) { A = ob; Bw = (const bf16_t*)(wl2 + WO_OUT); N_ = D; K_ = D; ssn2 = ssb + (size_t)(3 * gL + 1) * MT; }
                    else if (gkind == 3) { A = hb; Bw = (const bf16_t*)(wl2 + WO_GU); N_ = NGU; K_ = D; }
                    else if (gkind == 4) { A = act; Bw = (const bf16_t*)(wl2 + WO_DN); N_ = D; K_ = FFN; ssn2 = ssb + (size_t)(3 * gL + 2) * MT; }
                    else if (gkind == 5) { A = pb + (size_t)gL * MT * PLE; Bw = (const bf16_t*)(wl2 + WO_PL); N_ = D; K_ = PLE; }
                    else { A = hb; Bw = (const bf16_t*)(wl2 + WO_PG); N_ = D; K_ = D; ssn2 = ssb + (size_t)(3 * gL + 3) * MT; }
                    const pg8::Gemm g{A, Bw, MT, N_, K_}; const pg8::OneUnit S1{{128 + (gitem & 3), gitem >> 2}};
                    const AnyEpi E{gkind, gL, ws, out, x_sample, ssn2};
                    pg8::gemm_phase<AnyEpi, pg8::OneUnit, true, false>(lds, g, S1, E, wave);
                }
                if (got) {
                    asm volatile("s_waitcnt vmcnt(0)" ::: "memory");
                    __syncthreads();
                    if (tid == 0) {
                        const unsigned d = atomicAdd(chain + 64 * (32 + cst), 1u);
                        if (d + 1u == CHAIN_N(cst)) (void)atomicAdd(chain, 1u);
                    }
                }
            }
#undef CHAIN_N
            }
        }
#endif
        GRID_BARRIER();
#if EN_OUT
        {
            LAYER_PTRS(); const float* x_prompt = ap->in[0]; const float* x_sample = ap->in[1];
            const bf16_t* Bw = (const bf16_t*)(wl + WO_OUT);
            pg8::Gemm g{ob, Bw, MROWS, D, D}; pg8::StaticOrder S; S.init(MROWS, D, G, (int)blockIdx.x);
            BigEpi<RResid> E{{li == 0 ? x_prompt : hf, li == 0 ? x_sample : hf + (size_t)MP * D, hb2, H_BF16 ? nullptr : hf, hb, ss_ffn, false}};
            if (SAMPLE_SMALL) small_gemm(ob, Bw, D, D, E.e, wave, G);
            pg8::gemm_phase<BigEpi<RResid>, pg8::StaticOrder, true, true>(lds, g, S, E, wave);
        }
#endif
        GRID_BARRIER();
#if EN_GU
        for (int rep_ = 0; rep_ < GU_REP; ++rep_) {
            if (rep_) GRID_BARRIER();
            LAYER_PTRS();
            const bf16_t* Bw = (const bf16_t*)(wl + WO_GU);
            pg8::Gemm g{hb, Bw, MROWS, NGU, D}; pg8::StaticOrder S; S.init(MROWS, NGU, G, (int)blockIdx.x);
            BigEpi<RGateUp> E{{act, ss_ffn, nullptr, false}};
            if (SAMPLE_SMALL) small_gemm(hb, Bw, NGU, D, E.e, wave, G);
            pg8::gemm_phase<BigEpi<RGateUp>, pg8::StaticOrder, true, true>(lds, g, S, E, wave);
        }
#endif
        GRID_BARRIER();
#if EN_DN
        {
            LAYER_PTRS();
            const bf16_t* Bw = (const bf16_t*)(wl + WO_DN);
            pg8::Gemm g{act, Bw, MROWS, D, FFN}; pg8::StaticOrder S; S.init(MROWS, D, G, (int)blockIdx.x);
            BigEpi<RResid> E{{hf, hf + (size_t)MP * D, H_BF16 ? hb : nullptr, H_BF16 ? nullptr : hf, hb, ss_ple, false}};
            if (SAMPLE_SMALL) small_gemm(act, Bw, D, FFN, E.e, wave, G);
            pg8::gemm_phase<BigEpi<RResid>, pg8::StaticOrder, true, true>(lds, g, S, E, wave);
            { const bf16_t* Apl = pb + (size_t)li * MT * PLE; const bf16_t* Bw2 = (const bf16_t*)(wl + WO_PL); pg8::Gemm g2{Apl, Bw2, MROWS, D, PLE}; BigEpi<RPl> E2{{plb, nullptr, false}};
              __syncthreads();
              pg8::gemm_phase<BigEpi<RPl>, pg8::StaticOrder, false, true>(lds, g2, S, E2, wave); }
        }
#endif
        GRID_BARRIER();
#if EN_PLE
        {
            LAYER_PTRS();
            pg8::StaticOrder S; S.init(MROWS, D, G, (int)blockIdx.x);
            { const bf16_t* Bw = (const bf16_t*)(wl + WO_PG); pg8::Gemm g{hb, Bw, MROWS, D, D}; BigEpi<RPleGate> E{{plb, ss_ple, H_BF16 ? nullptr : hf, hb, hb2, ss_nxt, false}};
              if (SAMPLE_SMALL) small_gemm(hb, Bw, D, D, E.e, wave, G);
              pg8::gemm_phase<BigEpi<RPleGate>, pg8::StaticOrder, true, true>(lds, g, S, E, wave); }
        }
#endif
        GRID_BARRIER();
    }
    {
        ARGS_HERE(); WSPTRS(); LANE_TID(); float* out = ap->out; const float* norm_final = ap->in[25];
        const int gw = blockIdx.x * NWAVES + wave, NGW = G * NWAVES;
        const ss_t* ssf = ssb + (size_t)12 * MT;
        for (int r = gw; r < MT; r += NGW) {
            const float rs = ss_rs(ssf, r);
            float* yr = (r < MP) ? out + O_YP + (size_t)r * D : out + O_YS + (size_t)(r - MP) * D;
#pragma unroll
            for (int j = 0; j < 4; ++j) { const int c = 4 * lane + 256 * j; f32x4 v; if (H_BF16) { const u32x2 w = *(const u32x2*)(hb2 + (size_t)r * D + c); v = (f32x4){bf_lo(w.x), bf_hi(w.x), bf_lo(w.y), bf_hi(w.y)}; } else v = *(const f32x4*)(hf + (size_t)r * D + c);
                const f32x4 gv = *(const f32x4*)(norm_final + c); *(f32x4*)(yr + c) = v * rs * gv; }
        }
    }
}

extern "C" void kernel_launch(void* const* d_in, const int* in_sizes, int n_in, void* d_out, int out_size, void* d_ws, size_t ws_size, hipStream_t stream) {
    static int grid = 0;
    if (grid == 0) {
        if (n_in != 26 || (size_t)out_size != O_END || ws_size < WS_END) { fprintf(stderr, "kernel_launch: unexpected shapes: n_in %d out %d ws %zu (need %zu)\n", n_in, out_size, ws_size, (size_t)WS_END); grid = -1; return; }
        int dev = 0, cus = 0, per_cu = 0;
        if (hipGetDevice(&dev) != hipSuccess || hipDeviceGetAttribute(&cus, hipDeviceAttributeMultiprocessorCount, dev) != hipSuccess) { grid = -1; return; }
        if (hipFuncSetAttribute((const void*)trunk_fwd, hipFuncAttributeMaxDynamicSharedMemorySize, LDS_BYTES) != hipSuccess) { fprintf(stderr, "kernel_launch: hipFuncSetAttribute failed\n"); grid = -1; return; }
        if (hipOccupancyMaxActiveBlocksPerMultiprocessor(&per_cu, (const void*)trunk_fwd, NTHREADS, LDS_BYTES) != hipSuccess || per_cu < 1) { fprintf(stderr, "kernel_launch: occupancy query says %d\n", per_cu); }
        (void)hipGetLastError();
        grid = cus;
    }
    if (grid < 0) return;
    if (hipMemsetAsync((char*)d_ws + WS_CTL, 0, CTL_ZERO_BYTES, stream) != hipSuccess) return;
    Args a{};
    for (int i = 0; i < 26; ++i) a.in[i] = (const float*)d_in[i];
    a.out = (float*)d_out; a.ws = (unsigned char*)d_ws;
    hipLaunchKernelGGL(trunk_fwd, dim3(grid), dim3(NTHREADS), LDS_BYTES, stream, a);
}
```
